# Optimizing an MI355X kernel written in HIP

```python
import jax, jax.numpy as jnp
from jax import lax
import numpy as np

D_MODEL = 1024
BATCH = 32
SEQ = 2048
DEPTH = 1

CHUNK = 64
N_PREV_CHUNKS = 8
BAND = (N_PREV_CHUNKS + 1) * CHUNK

ATT_HEADS = 8
HEAD_DIM = 64
ATT_WIDTH = ATT_HEADS * HEAD_DIM
MAX_REL = 256

GMLP_GROUPS = 8
GMLP_GROUP_DIM = 64
GMLP_WIDTH = GMLP_GROUPS * GMLP_GROUP_DIM
GMLP_CHUNK = 128

MIX_WIDTH = GMLP_WIDTH + ATT_WIDTH
IN_WIDTH = 2 * GMLP_WIDTH + 3 * ATT_WIDTH
D_FF = 4 * D_MODEL

DEEPNORM_ALPHA = (2.0 * DEPTH) ** 0.25
DEEPNORM_BETA = (8.0 * DEPTH) ** -0.25
LN_EPS = 1e-5
RMS_EPS = 1e-6

kernel_name = "hybrid_gmlp_chunkattn_deepnorm"


def _layer_norm(x, g, b):
    xf = x.astype(jnp.float32)
    mu = jnp.mean(xf, axis=-1, keepdims=True)
    var = jnp.mean(jnp.square(xf - mu), axis=-1, keepdims=True)
    return ((xf - mu) * lax.rsqrt(var + LN_EPS) * g + b).astype(x.dtype)


def _rms_norm(x, g):
    xf = x.astype(jnp.float32)
    ms = jnp.mean(jnp.square(xf), axis=-1, keepdims=True)
    return (xf * lax.rsqrt(ms + RMS_EPS) * g).astype(x.dtype)


def _gmlp_spatial_gate(u, v, ln_g, ln_b, w_s, b_s):
    B, S, _ = u.shape
    nw = S // GMLP_CHUNK
    v = v.reshape(B, nw, GMLP_CHUNK, GMLP_GROUPS, GMLP_GROUP_DIM)
    vn = _layer_norm(v, ln_g, ln_b)
    pos = jnp.arange(GMLP_CHUNK)
    mask = (pos[:, None] // CHUNK) >= (pos[None, :] // CHUNK)
    w = jnp.where(mask[None], w_s, jnp.zeros_like(w_s))
    vm = jnp.einsum('gij,bwjgc->bwigc', w, vn) + jnp.transpose(b_s)[None, None, :, :, None]
    return u * vm.reshape(B, S, GMLP_WIDTH)


def _rel_bias(rel_table):
    i = jnp.arange(CHUNK)[:, None]
    m = jnp.arange(BAND)[None, :]
    dist = i + N_PREV_CHUNKS * CHUNK - m
    idx = jnp.clip(dist, -MAX_REL, MAX_REL) + MAX_REL
    return rel_table[:, idx]


def _chunked_band_attention(q, k, v, rel_table):
    B, S, _ = q.shape
    nc = S // CHUNK
    pad = N_PREV_CHUNKS * CHUNK
    qc_all = jnp.transpose(q.reshape(B, nc, CHUNK, ATT_HEADS, HEAD_DIM), (1, 0, 2, 3, 4))
    kp = jnp.pad(k.reshape(B, S, ATT_HEADS, HEAD_DIM), ((0, 0), (pad, 0), (0, 0), (0, 0)))
    vp = jnp.pad(v.reshape(B, S, ATT_HEADS, HEAD_DIM), ((0, 0), (pad, 0), (0, 0), (0, 0)))
    bias = _rel_bias(rel_table).astype(jnp.float32)[None]
    scale = HEAD_DIM ** -0.5
    key_offset = jnp.arange(BAND) - pad

    def one_chunk(args):
        qc, c = args
        kc = lax.dynamic_slice_in_dim(kp, c * CHUNK, BAND, axis=1)
        vc = lax.dynamic_slice_in_dim(vp, c * CHUNK, BAND, axis=1)
        s = jnp.einsum('bihd,bjhd->bhij', qc, kc,
                       preferred_element_type=jnp.float32) * scale + bias
        valid = (c * CHUNK + key_offset) >= 0
        s = jnp.where(valid[None, None, None, :], s, -jnp.inf)
        p = jax.nn.softmax(s, axis=-1).astype(vc.dtype)
        return jnp.einsum('bhij,bjhd->bihd', p, vc)

    out = lax.map(one_chunk, (qc_all, jnp.arange(nc)))
    return jnp.transpose(out, (1, 0, 2, 3, 4)).reshape(B, S, ATT_WIDTH)


def setup_inputs(seed: int = 0) -> dict:
    key = jax.random.key(seed)
    ks = jax.random.split(key, 20)
    f32 = jnp.float32
    x = jax.random.normal(ks[0], (BATCH, SEQ, D_MODEL), f32)

    col_scale = jnp.concatenate([
        jnp.full((2 * GMLP_WIDTH,), DEEPNORM_BETA, f32),
        jnp.ones((2 * ATT_WIDTH,), f32),
        jnp.full((ATT_WIDTH,), DEEPNORM_BETA, f32)])
    w_in = jax.random.normal(ks[1], (DEPTH, D_MODEL, IN_WIDTH), f32) * (D_MODEL ** -0.5) * col_scale

    gmlp_ln_g = 1.0 + 0.02 * jax.random.normal(ks[2], (DEPTH, GMLP_GROUPS, GMLP_GROUP_DIM), f32)
    gmlp_ln_b = 0.02 * jax.random.normal(ks[3], (DEPTH, GMLP_GROUPS, GMLP_GROUP_DIM), f32)
    w_spatial = 0.5 * (GMLP_CHUNK ** -0.5) * jax.random.normal(
        ks[4], (DEPTH, GMLP_GROUPS, GMLP_CHUNK, GMLP_CHUNK), f32)
    b_spatial = 1.0 + 0.02 * jax.random.normal(ks[5], (DEPTH, GMLP_GROUPS, GMLP_CHUNK), f32)

    rel_bias = 0.5 * jax.random.normal(ks[6], (DEPTH, ATT_HEADS, 2 * MAX_REL + 1), f32)

    gate_g_gmlp = 1.0 + 0.02 * jax.random.normal(ks[7], (DEPTH, GMLP_WIDTH), f32)
    gate_g_attn = 1.0 + 0.02 * jax.random.normal(ks[8], (DEPTH, ATT_WIDTH), f32)
    w_out = jax.random.normal(ks[9], (DEPTH, MIX_WIDTH, D_MODEL), f32) * (MIX_WIDTH ** -0.5) * DEEPNORM_BETA
    ln1_g = 1.0 + 0.02 * jax.random.normal(ks[10], (DEPTH, D_MODEL), f32)
    ln1_b = 0.02 * jax.random.normal(ks[11], (DEPTH, D_MODEL), f32)

    w_ff1 = jax.random.normal(ks[12], (DEPTH, D_MODEL, D_FF), f32) * (D_MODEL ** -0.5) * DEEPNORM_BETA
    w_ff2 = jax.random.normal(ks[13], (DEPTH, D_FF, D_MODEL), f32) * (D_FF ** -0.5) * DEEPNORM_BETA
    ln2_g = 1.0 + 0.02 * jax.random.normal(ks[14], (DEPTH, D_MODEL), f32)
    ln2_b = 0.02 * jax.random.normal(ks[15], (DEPTH, D_MODEL), f32)
    return {"x": x, "w_in": w_in, "gmlp_ln_g": gmlp_ln_g, "gmlp_ln_b": gmlp_ln_b,
            "w_spatial": w_spatial, "b_spatial": b_spatial, "rel_bias": rel_bias,
            "gate_g_gmlp": gate_g_gmlp, "gate_g_attn": gate_g_attn, "w_out": w_out,
            "ln1_g": ln1_g, "ln1_b": ln1_b, "w_ff1": w_ff1, "w_ff2": w_ff2,
            "ln2_g": ln2_g, "ln2_b": ln2_b}


def reference(x, w_in, gmlp_ln_g, gmlp_ln_b, w_spatial, b_spatial, rel_bias,
              gate_g_gmlp, gate_g_attn, w_out, ln1_g, ln1_b, w_ff1, w_ff2, ln2_g, ln2_b):
    h = x
    splits = [GMLP_WIDTH, 2 * GMLP_WIDTH, 2 * GMLP_WIDTH + ATT_WIDTH, 2 * GMLP_WIDTH + 2 * ATT_WIDTH]
    for l in range(DEPTH):
        z = jnp.einsum('bsd,de->bse', h, w_in[l])
        zu, zv, q, k, v = jnp.split(z, splits, axis=-1)
        y_a = _gmlp_spatial_gate(jax.nn.gelu(zu), jax.nn.gelu(zv),
                                 gmlp_ln_g[l], gmlp_ln_b[l], w_spatial[l], b_spatial[l])
        y_b = _chunked_band_attention(q, k, v, rel_bias[l])
        y = jnp.concatenate([_rms_norm(y_a, gate_g_gmlp[l]), _rms_norm(y_b, gate_g_attn[l])], axis=-1)
        h = _layer_norm(DEEPNORM_ALPHA * h + jnp.einsum('bse,ed->bsd', y, w_out[l]), ln1_g[l], ln1_b[l])
        f = jnp.einsum('bsf,fd->bsd', jnp.square(jax.nn.relu(jnp.einsum('bsd,df->bsf', h, w_ff1[l]))), w_ff2[l])
        h = _layer_norm(DEEPNORM_ALPHA * h + f, ln2_g[l], ln2_b[l])
    return h
```

```cpp
#include <hip/hip_runtime.h>
#include <hip/hip_cooperative_groups.h>
#include <cstdio>
#include <cstdint>
namespace cg = cooperative_groups;
namespace pg8 {
#define PG8_LAS __attribute__((address_space(3)))
typedef unsigned short bf16_t;
typedef short bf16x8 __attribute__((ext_vector_type(8)));
typedef float f32x4 __attribute__((ext_vector_type(4)));
typedef unsigned u32x4 __attribute__((ext_vector_type(4)));
constexpr int BM = 256, BK = 64, HALF = 128, HTB = HALF * BK * 2  , STAGE_BYTES = 8 * HTB, NXCD = 8, WGM = 8;

__host__ __device__ __forceinline__ int lds_byte(int r, int c) { const int st = (r >> 4) * 2 + (c >> 5), rr = r & 15, cc = c & 31, ob = rr * 64 + cc * 2; return st * 1024 + (ob ^ (((ob >> 9) & 1) << 5)); }
__host__ __device__ __forceinline__ void stage_rc(int b, int& R, int& C) { const int st = b / 1024, sb = b % 1024, swz = sb ^ (((sb >> 9) & 1) << 5); R = (st >> 1) * 16 + swz / 64; C = (st & 1) * 32 + (swz % 64) / 2; }
__host__ __device__ __forceinline__ int perm32(int rho) { const int n = rho >> 4, i = rho & 15; return 8 * (i >> 2) + 4 * n + (i & 3); }

struct Unit { int pm, pn; };
struct Gemm { const bf16_t* A; const bf16_t* Bt; int M, N, K; };

struct StaticOrder {
    int nM, nN, nwg, G, c;
    __host__ __device__ void init(int M, int N, int G_, int c_) { nM = M / BM; nN = N / BM; nwg = nM * nN; G = G_; c = c_; }
    __host__ __device__ bool next(int i, Unit& u) const {
        const long L = (long)i * G + c; if (L >= nwg) return false;
        int wgid = (int)L; { const int q = nwg / NXCD, r = nwg % NXCD, xcd = wgid % NXCD, off = wgid / NXCD; wgid = (xcd < r ? xcd * (q + 1) : r * (q + 1) + (xcd - r) * q) + off; }
        const int nig = WGM * nN, gid = wgid / nig, fm = gid * WGM, gsz = (nM - fm) < WGM ? (nM - fm) : WGM;
        u.pm = fm + ((wgid % nig) % gsz); u.pn = (wgid % nig) / gsz; return true;
    }
    __device__ __forceinline__ void a_ready(const Unit&) const {}
    __device__ __forceinline__ void done(const Unit&) const {}
};

__device__ __forceinline__ unsigned cvt_pk_bf16(float lo, float hi) { unsigned r; asm volatile("v_cvt_pk_bf16_f32 %0, %1, %2" : "=v"(r) : "v"(lo), "v"(hi)); return r; }
typedef float f32x2 __attribute__((ext_vector_type(2)));
__device__ __forceinline__ float gelu_tanh(float v) {
    const float u = v * (0.7978845608028654f + 0.035677408136300125f * v * v);
    const float e = __builtin_amdgcn_exp2f(-2.8853900817779268f * u);
    return v * __builtin_amdgcn_rcpf(1.0f + e);
}
template <int ACT> struct EpiAct {
    static constexpr bool PERM = true, AFTER_DRAIN = false;
    bf16_t* O; int ldc; int nact;
    __device__ __forceinline__ void operator()(const f32x4 (&acc)[2][2][4][2], const Unit& u, int wr, int wc, int fr, int fq) const {
        const int row0 = u.pm * BM + wr * 64 + fr; const int col0 = u.pn * BM + wc * 32 + 8 * fq;
        const bool act = (ACT == 1) && (u.pn < nact);
#pragma unroll
        for (int ai = 0; ai < 2; ++ai)
#pragma unroll
            for (int m = 0; m < 4; ++m) { bf16_t* rowp = O + (size_t)(row0 + ai * HALF + m * 16) * ldc + col0;
#pragma unroll
                for (int bj = 0; bj < 2; ++bj) { f32x4 v0 = acc[ai][bj][m][0], v1 = acc[ai][bj][m][1];
                    if (ACT == 1) { if (act) {
#pragma unroll
                        for (int e = 0; e < 4; ++e) { v0[e] = gelu_tanh(v0[e]); v1[e] = gelu_tanh(v1[e]); } } }
                    if (ACT == 2) {
#pragma unroll
                        for (int e = 0; e < 4; ++e) { const float a = fmaxf(v0[e], 0.f), b = fmaxf(v1[e], 0.f); v0[e] = a * a; v1[e] = b * b; } }
                    u32x4 w; w.x = cvt_pk_bf16(v0[0], v0[1]); w.y = cvt_pk_bf16(v0[2], v0[3]); w.z = cvt_pk_bf16(v1[0], v1[1]); w.w = cvt_pk_bf16(v1[2], v1[3]);
                    *(u32x4*)(rowp + bj * HALF) = w; } }
    }
};
struct EpiRes {
    static constexpr bool PERM = false, AFTER_DRAIN = false;
    const float* res; float* out; int ldc; float alpha;
    __device__ __forceinline__ void operator()(const f32x4 (&acc)[2][2][4][2], const Unit& u, int wr, int wc, int fr, int fq) const {
        const int col0 = u.pn * BM + wc * 32 + 4 * fq;
#pragma unroll
        for (int ai = 0; ai < 2; ++ai)
#pragma unroll
            for (int m = 0; m < 4; ++m) { const int r = u.pm * BM + ai * HALF + wr * 64 + m * 16 + fr; const size_t off = (size_t)r * ldc + col0;
#pragma unroll
                for (int bj = 0; bj < 2; ++bj)
#pragma unroll
                    for (int n = 0; n < 2; ++n) { const f32x4 bs = *(const f32x4*)(res + off + bj * HALF + n * 16); const f32x4 o = bs * alpha + acc[ai][bj][m][n];
                        *(f32x4*)(out + off + bj * HALF + n * 16) = o; }
                if (m & 1) asm volatile("" ::: "memory"); }
    }
};

template <class Epi, class Sched, bool ALIGN_EPI = false, bool SP2 = false>
__device__ __forceinline__ void gemm_phase(PG8_LAS unsigned char* lds, const Gemm g, const Sched& S, const Epi& E) {
    const int tid = threadIdx.x, wid = __builtin_amdgcn_readfirstlane(tid >> 6), lane = tid & 63, wr = wid >> 2, wc = wid & 3, fr = lane & 15, fq = lane >> 4;
    const int K = g.K, nt = K / BK;
    unsigned voffA[2], voffB[2];
#pragma unroll
    for (int i = 0; i < 2; ++i) { int R, C; stage_rc(tid * 16 + i * 8192, R, C); const int Rb = Epi::PERM ? ((R & ~31) + perm32(R & 31)) : R;
        voffA[i] = (unsigned)(R * K + C) * 2u; voffB[i] = (unsigned)(Rb * K + C) * 2u; }
    const size_t kstep = (size_t)(BK * 2);
    const size_t hstep = (size_t)HALF * K * 2;
    const size_t tstep = 2 * hstep;
    const unsigned ldsw = (unsigned)wid * 1024u;
    const int aoff = lds_byte(wr * 64 + fr, fq * 8), boff = lds_byte(wc * 32 + fr, fq * 8);
#define PG8_SA(b, h) (((b) * 2 + (h)) * HTB)
#define PG8_SB(b, h) ((4 + (b) * 2 + (h)) * HTB)
#define PG8_STAGE(bufoff, gbase, voff) do { _Pragma("unroll") for (int _i = 0; _i < 2; ++_i) \
        __builtin_amdgcn_global_load_lds((const unsigned*)((const char*)(gbase) + (voff)[_i]), (PG8_LAS unsigned*)(lds + (bufoff) + ldsw + _i * 8192), 16, 0, 0); } while (0)
#define PG8_LDA(dst, b, h) do { _Pragma("unroll") for (int m = 0; m < 4; ++m) _Pragma("unroll") for (int k = 0; k < 2; ++k) dst[m][k] = *(const PG8_LAS bf16x8*)(lds + PG8_SA(b, h) + aoff + m * 2048 + k * 1024); } while (0)
#define PG8_LDB(dst, b, h) do { _Pragma("unroll") for (int n = 0; n < 2; ++n) _Pragma("unroll") for (int k = 0; k < 2; ++k) dst[n][k] = *(const PG8_LAS bf16x8*)(lds + PG8_SB(b, h) + boff + n * 2048 + k * 1024); } while (0)
#define PG8_MMA(ai, bj, At, Bt) do { __builtin_amdgcn_s_setprio(1); _Pragma("unroll") for (int m = 0; m < 4; ++m) _Pragma("unroll") for (int n = 0; n < 2; ++n) _Pragma("unroll") for (int k = 0; k < 2; ++k) \
        acc[ai][bj][m][n] = __builtin_amdgcn_mfma_f32_16x16x32_bf16(Bt[n][k], At[m][k], acc[ai][bj][m][n], 0, 0, 0); __builtin_amdgcn_s_setprio(0); } while (0)
#define PG8_WAIT_V(n) asm volatile("s_waitcnt vmcnt(" #n ")" ::: "memory")
#define PG8_WAIT_L(n) asm volatile("s_waitcnt lgkmcnt(" #n ")" ::: "memory")
#define PG8_BAR __builtin_amdgcn_s_barrier()
#define PG8_SCHED __builtin_amdgcn_sched_barrier(0)
    Unit cur, nxt; int ui = 0;
    if (!S.next(0, cur)) return;
    f32x4 acc[2][2][4][2];
#pragma unroll
    for (int a = 0; a < 2; ++a)
#pragma unroll
        for (int b = 0; b < 2; ++b)
#pragma unroll
            for (int m = 0; m < 4; ++m)
#pragma unroll
                for (int n = 0; n < 2; ++n) acc[a][b][m][n] = (f32x4){0.f, 0.f, 0.f, 0.f};
    bf16x8 At[4][2], B0[2][2], B1[2][2];
    const char* cA = (const char*)g.A + (size_t)cur.pm * tstep; const char* cB = (const char*)g.Bt + (size_t)cur.pn * tstep;
    S.a_ready(cur);
    if constexpr (SP2) {
        PG8_STAGE(PG8_SB(0, 0), cB, voffB); PG8_STAGE(PG8_SB(0, 1), cB + hstep, voffB); PG8_STAGE(PG8_SA(0, 0), cA, voffA); PG8_STAGE(PG8_SA(0, 1), cA + hstep, voffA);
        if (wr == 1) PG8_BAR;
        PG8_WAIT_V(2); PG8_BAR;
        PG8_STAGE(PG8_SB(1, 0), cB + kstep, voffB); PG8_STAGE(PG8_SA(1, 0), cA + kstep, voffA); PG8_STAGE(PG8_SB(1, 1), cB + hstep + kstep, voffB);
        PG8_WAIT_V(6); PG8_BAR;
    } else {
        PG8_STAGE(PG8_SB(0, 0), cB, voffB); PG8_STAGE(PG8_SA(0, 0), cA, voffA); PG8_STAGE(PG8_SB(0, 1), cB + hstep, voffB); PG8_STAGE(PG8_SA(0, 1), cA + hstep, voffA);
        if (wr == 1) PG8_BAR;
        PG8_WAIT_V(4); PG8_BAR;
        PG8_STAGE(PG8_SB(1, 0), cB + kstep, voffB); PG8_STAGE(PG8_SA(1, 0), cA + kstep, voffA); PG8_STAGE(PG8_SB(1, 1), cB + hstep + kstep, voffB);
        PG8_WAIT_V(6); PG8_BAR;
    }
    for (;;) {
        const bool has_next = S.next(ui + 1, nxt);
        const char* nA = has_next ? (const char*)g.A + (size_t)nxt.pm * tstep : cA; const char* nB = has_next ? (const char*)g.Bt + (size_t)nxt.pn * tstep : cB;
        for (int t = 0; t < nt; t += 2) {
            const bool last = (t == nt - 2);
            const char* a1 = cA + (size_t)(t + 1) * kstep;
            const char* a2 = last ? nA : cA + (size_t)(t + 2) * kstep; const char* b2 = last ? nB : cB + (size_t)(t + 2) * kstep;
            const char* a3 = a2 + kstep; const char* b3 = b2 + kstep;
            if (last && has_next) S.a_ready(nxt);
            if constexpr (SP2) {
            PG8_LDB(B0, 0, 0); PG8_LDB(B1, 0, 1); PG8_SCHED; PG8_LDA(At, 0, 0); PG8_STAGE(PG8_SA(1, 1), a1 + hstep, voffA);
            PG8_WAIT_V(8); PG8_WAIT_L(0); PG8_BAR; PG8_MMA(0, 0, At, B0); PG8_MMA(0, 1, At, B1); PG8_BAR; PG8_SCHED;
            PG8_LDA(At, 0, 1); PG8_STAGE(PG8_SB(0, 0), b2, voffB); PG8_STAGE(PG8_SB(0, 1), b2 + hstep, voffB); PG8_STAGE(PG8_SA(0, 0), a2, voffA);
            PG8_WAIT_V(8); PG8_WAIT_L(0); PG8_BAR; PG8_MMA(1, 0, At, B0); PG8_MMA(1, 1, At, B1); PG8_BAR; PG8_SCHED;
            PG8_LDB(B0, 1, 0); PG8_LDB(B1, 1, 1); PG8_SCHED; PG8_LDA(At, 1, 0); PG8_STAGE(PG8_SA(0, 1), a2 + hstep, voffA);
            PG8_WAIT_V(8); PG8_WAIT_L(0); PG8_BAR; PG8_MMA(0, 0, At, B0); PG8_MMA(0, 1, At, B1); PG8_BAR; PG8_SCHED;
            PG8_LDA(At, 1, 1); PG8_STAGE(PG8_SB(1, 0), b3, voffB); PG8_STAGE(PG8_SB(1, 1), b3 + hstep, voffB); PG8_STAGE(PG8_SA(1, 0), a3, voffA);
            PG8_WAIT_V(8); PG8_WAIT_L(0); PG8_BAR; PG8_MMA(1, 0, At, B0); PG8_MMA(1, 1, At, B1); PG8_BAR; PG8_SCHED;
            } else {
            PG8_LDB(B0, 0, 0); PG8_SCHED; PG8_LDA(At, 0, 0); PG8_STAGE(PG8_SA(1, 1), a1 + hstep, voffA);
            PG8_WAIT_L(8); PG8_BAR; PG8_WAIT_L(0); PG8_MMA(0, 0, At, B0); PG8_BAR; PG8_SCHED;
            PG8_LDB(B1, 0, 1); PG8_STAGE(PG8_SB(0, 0), b2, voffB);
            PG8_BAR; PG8_WAIT_L(0); PG8_MMA(0, 1, At, B1); PG8_BAR;
            PG8_LDA(At, 0, 1); PG8_STAGE(PG8_SA(0, 0), a2, voffA);
            PG8_BAR; PG8_WAIT_L(0); PG8_MMA(1, 0, At, B0); PG8_BAR; PG8_SCHED;
            PG8_STAGE(PG8_SB(0, 1), b2 + hstep, voffB);
            PG8_WAIT_V(6); PG8_BAR; PG8_MMA(1, 1, At, B1); PG8_BAR;
            PG8_LDB(B0, 1, 0); PG8_SCHED; PG8_LDA(At, 1, 0); PG8_STAGE(PG8_SA(0, 1), a2 + hstep, voffA);
            PG8_WAIT_L(8); PG8_BAR; PG8_WAIT_L(0); PG8_MMA(0, 0, At, B0); PG8_BAR; PG8_SCHED;
            PG8_LDB(B1, 1, 1); PG8_STAGE(PG8_SB(1, 0), b3, voffB);
            PG8_BAR; PG8_WAIT_L(0); PG8_MMA(0, 1, At, B1); PG8_BAR;
            PG8_LDA(At, 1, 1); PG8_STAGE(PG8_SA(1, 0), a3, voffA);
            PG8_BAR; PG8_WAIT_L(0); PG8_MMA(1, 0, At, B0); PG8_BAR; PG8_SCHED;
            PG8_STAGE(PG8_SB(1, 1), b3 + hstep, voffB);
            PG8_WAIT_V(6); PG8_BAR; PG8_MMA(1, 1, At, B1); PG8_BAR;
            }
        }
        if constexpr (ALIGN_EPI) { if (wr == 0) PG8_BAR; }
        if constexpr (!Epi::AFTER_DRAIN) { E(acc, cur, wr, wc, fr, fq); S.done(cur); }
        if (!has_next) break;
#pragma unroll
        for (int a = 0; a < 2; ++a)
#pragma unroll
            for (int b = 0; b < 2; ++b)
#pragma unroll
                for (int m = 0; m < 4; ++m)
#pragma unroll
                    for (int n = 0; n < 2; ++n) acc[a][b][m][n] = (f32x4){0.f, 0.f, 0.f, 0.f};
        cur = nxt; cA = nA; cB = nB; ++ui;
        if constexpr (ALIGN_EPI) { if (wr == 1) PG8_BAR; }
    }
    PG8_WAIT_V(0);
    if constexpr (!ALIGN_EPI) { if (wr == 0) PG8_BAR; }
    PG8_BAR;
    if constexpr (Epi::AFTER_DRAIN) { E.fused(acc, cur, wr, wc, fr, fq, lds, wid, lane); S.done(cur); }
#undef PG8_SA
#undef PG8_SB
#undef PG8_STAGE
#undef PG8_LDA
#undef PG8_LDB
#undef PG8_MMA
#undef PG8_WAIT_V
#undef PG8_WAIT_L
#undef PG8_BAR
#undef PG8_SCHED
}
}
constexpr int M_ = 65536, D_ = 1024, INW = 2560, FF_ = 4096;
constexpr float ALPHA = 1.189207115002721f;
constexpr size_t MiB = 1u << 20;
constexpr size_t WS_WIN = 2 * MiB, WS_WOUT = 8 * MiB, WS_W1 = 10 * MiB, WS_W2 = 18 * MiB, WS_WSM = 26 * MiB;
constexpr size_t WS_XB = 32 * MiB;
constexpr size_t WS_Z = 160 * MiB;
constexpr size_t WS_Y = 480 * MiB;
constexpr size_t WS_F = 32 * MiB;
constexpr size_t WS_H1 = 608 * MiB;
constexpr size_t WS_H1B = 864 * MiB;
constexpr size_t WS_END = 992 * MiB;
constexpr size_t WS_YT = WS_H1;
constexpr size_t WS_VN = WS_H1B;
constexpr int LDS_BYTES = 147456;

#define LAS __attribute__((address_space(3)))
typedef unsigned short bf16;
typedef unsigned v4u __attribute__((ext_vector_type(4)));
typedef unsigned v2u __attribute__((ext_vector_type(2)));
typedef float f32x4 __attribute__((ext_vector_type(4)));
typedef float f32x2_t __attribute__((ext_vector_type(2)));
typedef __bf16 bf16x2_t __attribute__((ext_vector_type(2)));
__device__ __forceinline__ unsigned pkbf(float lo, float hi) { f32x2_t v = {lo, hi}; bf16x2_t b = __builtin_convertvector(v, bf16x2_t); return __builtin_bit_cast(unsigned, b); }
__device__ __forceinline__ float bflo(unsigned w) { return __uint_as_float(w << 16); }
__device__ __forceinline__ float bfhi(unsigned w) { return __uint_as_float(w & 0xffff0000u); }
__device__ __forceinline__ float wave_sum(float v) {
#pragma unroll
    for (int o = 1; o < 64; o <<= 1) v += __shfl_xor(v, o);
    return v;
}

struct Params { const float* in[16]; float* out; unsigned char* ws; };

__device__ __forceinline__ void transpose_item(const float* W, int K, int N, bf16* WT, LAS float* scr, int item, int lane) {
    const int nblk = N / 32, kb = item / nblk, nb = item % nblk, k0 = 64 * kb, n0 = 32 * nb;
#pragma unroll 8
    for (int i = 0; i < 32; ++i) { const int kk = 2 * i + (lane >> 5); scr[kk * 33 + (lane & 31)] = W[(size_t)(k0 + kk) * N + n0 + (lane & 31)]; }
    asm volatile("s_waitcnt lgkmcnt(0)" ::: "memory");
    const int c = lane & 7;
#pragma unroll
    for (int j = 0; j < 4; ++j) { const int n = (lane >> 3) + 8 * j; const LAS float* s = scr + (8 * c) * 33 + n;
        v4u o; o.x = pkbf(s[0 * 33], s[1 * 33]); o.y = pkbf(s[2 * 33], s[3 * 33]); o.z = pkbf(s[4 * 33], s[5 * 33]); o.w = pkbf(s[6 * 33], s[7 * 33]);
        *(v4u*)(WT + (size_t)(n0 + n) * K + k0 + 8 * c) = o; }
    asm volatile("s_waitcnt lgkmcnt(0)" ::: "memory");
}
__device__ __forceinline__ void prologue(const Params& p, LAS unsigned char* lds, int tid, int lane, int wave) {
    unsigned char* ws = p.ws;
    LAS float* scr = (LAS float*)(lds + wave * 16384);
    const int gw = blockIdx.x * 8 + wave, NGW = gridDim.x * 8;
    constexpr int I_IN = (D_ / 64) * (INW / 32), I_O = (D_ / 64) * (D_ / 32), I_1 = (D_ / 64) * (FF_ / 32), I_2 = (FF_ / 64) * (D_ / 32);
    constexpr int NITEMS = I_IN + I_O + I_1 + I_2;
    for (int it = gw; it < NITEMS; it += NGW) {
        int r = it;
        if (r < I_IN) { transpose_item(p.in[1], D_, INW, (bf16*)(ws + WS_WIN), scr, r, lane); continue; } r -= I_IN;
        if (r < I_O) { transpose_item(p.in[9], D_, D_, (bf16*)(ws + WS_WOUT), scr, r, lane); continue; } r -= I_O;
        if (r < I_1) { transpose_item(p.in[12], D_, FF_, (bf16*)(ws + WS_W1), scr, r, lane); continue; } r -= I_1;
        transpose_item(p.in[13], FF_, D_, (bf16*)(ws + WS_W2), scr, r, lane);
    }
    const int gtid = blockIdx.x * 512 + tid, NT = gridDim.x * 512;
    { const float* wsp = p.in[4]; bf16* wsm = (bf16*)(ws + WS_WSM);
      for (int v = gtid; v < 8 * 128 * 128 / 8; v += NT) { const int e = v * 8, i = (e >> 7) & 127, j = e & 127; const bool z = (i < 64) && (j >= 64);
          const f32x4 a = *(const f32x4*)(wsp + e), b = *(const f32x4*)(wsp + e + 4);
          v4u o; o.x = pkbf(a[0], a[1]); o.y = pkbf(a[2], a[3]); o.z = pkbf(b[0], b[1]); o.w = pkbf(b[2], b[3]); if (z) o = (v4u){0u, 0u, 0u, 0u};
          *(v4u*)(wsm + e) = o; } }
    { const f32x4* x4 = (const f32x4*)p.in[0]; v4u* xb = (v4u*)(ws + WS_XB);
      for (size_t v = (size_t)gtid; v < (size_t)M_ * D_ / 8; v += (size_t)NT) { const f32x4 a = x4[2 * v], b = x4[2 * v + 1];
          v4u o; o.x = pkbf(a[0], a[1]); o.y = pkbf(a[2], a[3]); o.z = pkbf(b[0], b[1]); o.w = pkbf(b[2], b[3]); xb[v] = o; } }
}

__device__ __forceinline__ void ln_rows(const float* T, const float* g, const float* b, float* outf, bf16* outb, int lane, int wave) {
    const int gw = blockIdx.x * 8 + wave, NGW = gridDim.x * 8;
    f32x4 gv[4], bv[4];
#pragma unroll
    for (int j = 0; j < 4; ++j) { gv[j] = ((const f32x4*)g)[lane + 64 * j]; bv[j] = ((const f32x4*)b)[lane + 64 * j]; }
    for (int r = gw; r < M_; r += NGW) {
        const f32x4* tr = (const f32x4*)(T + (size_t)r * D_) + lane;
        f32x4 v[4]; float s = 0.f;
#pragma unroll
        for (int j = 0; j < 4; ++j) { v[j] = tr[64 * j]; s += (v[j][0] + v[j][1]) + (v[j][2] + v[j][3]); }
        const float mean = wave_sum(s) * (1.f / D_); float s2 = 0.f;
#pragma unroll
        for (int j = 0; j < 4; ++j) { v[j] = v[j] - mean; s2 += (v[j][0] * v[j][0] + v[j][1] * v[j][1]) + (v[j][2] * v[j][2] + v[j][3] * v[j][3]); }
        const float rstd = 1.f / sqrtf(wave_sum(s2) * (1.f / D_) + 1e-5f);
#pragma unroll
        for (int j = 0; j < 4; ++j) { const f32x4 o = v[j] * rstd * gv[j] + bv[j];
            if (outf) ((f32x4*)(outf + (size_t)r * D_))[lane + 64 * j] = o;
            if (outb) { v2u w; w.x = pkbf(o[0], o[1]); w.y = pkbf(o[2], o[3]); ((v2u*)(outb + (size_t)r * D_))[lane + 64 * j] = w; } }
    }
}
__device__ __forceinline__ void rms_rows(const float* Yt, const float* gA, const float* gB, bf16* Y, int lane, int wave) {
    const int gw = blockIdx.x * 8 + wave, NGW = gridDim.x * 8;
    f32x4 gv[4];
#pragma unroll
    for (int j = 0; j < 2; ++j) { gv[j] = ((const f32x4*)gA)[lane + 64 * j]; gv[2 + j] = ((const f32x4*)gB)[lane + 64 * j]; }
    for (int r = gw; r < M_; r += NGW) {
        const f32x4* tr = (const f32x4*)(Yt + (size_t)r * D_) + lane;
        f32x4 v[4]; float sq[4];
#pragma unroll
        for (int j = 0; j < 4; ++j) { v[j] = tr[64 * j]; sq[j] = (v[j][0] * v[j][0] + v[j][1] * v[j][1]) + (v[j][2] * v[j][2] + v[j][3] * v[j][3]); }
        const float rA = 1.f / sqrtf(wave_sum(sq[0] + sq[1]) * (1.f / 512.f) + 1e-6f), rB = 1.f / sqrtf(wave_sum(sq[2] + sq[3]) * (1.f / 512.f) + 1e-6f);
#pragma unroll
        for (int j = 0; j < 4; ++j) { const f32x4 o = v[j] * (j < 2 ? rA : rB) * gv[j];
            v2u w; w.x = pkbf(o[0], o[1]); w.y = pkbf(o[2], o[3]); ((v2u*)(Y + (size_t)r * D_))[lane + 64 * j] = w; }
    }
}

#define UNPACK8(w, f) do { f[0] = bflo(w.x); f[1] = bfhi(w.x); f[2] = bflo(w.y); f[3] = bfhi(w.y); f[4] = bflo(w.z); f[5] = bfhi(w.z); f[6] = bflo(w.w); f[7] = bfhi(w.w); } while (0)
__device__ __forceinline__ void naive_vn(const bf16* Z, const float* lg, const float* lb, bf16* VN, int gtid, int NT) {
    for (int idx = gtid; idx < M_ * 8; idx += NT) {
        const int tok = idx >> 3, g = idx & 7;
        const v4u* zr = (const v4u*)(Z + (size_t)tok * INW + 512 + g * 64);
        float v[64]; float s = 0.f;
#pragma unroll
        for (int t = 0; t < 8; ++t) { const v4u w = zr[t]; float f[8]; UNPACK8(w, f);
#pragma unroll
            for (int e = 0; e < 8; ++e) { v[t * 8 + e] = f[e]; s += f[e]; } }
        const float mean = s * (1.f / 64.f); float s2 = 0.f;
#pragma unroll
        for (int c = 0; c < 64; ++c) { v[c] -= mean; s2 += v[c] * v[c]; }
        const float rstd = 1.f / sqrtf(s2 * (1.f / 64.f) + 1e-5f);
        v4u* o = (v4u*)(VN + (size_t)tok * 512 + g * 64);
#pragma unroll
        for (int t = 0; t < 8; ++t) { float y[8];
#pragma unroll
            for (int e = 0; e < 8; ++e) { const int c = t * 8 + e; y[e] = v[c] * rstd * lg[g * 64 + c] + lb[g * 64 + c]; }
            v4u w; w.x = pkbf(y[0], y[1]); w.y = pkbf(y[2], y[3]); w.z = pkbf(y[4], y[5]); w.w = pkbf(y[6], y[7]); o[t] = w; }
    }
}
__device__ __forceinline__ void naive_gmlp(const bf16* Z, const bf16* VN, const float* wsp, const float* bsp, float* Yt, int gtid, int NT) {
    for (int idx = gtid; idx < M_ * 8; idx += NT) {
        const int i = idx & 127, g = (idx >> 7) & 7, win = idx >> 10, tok = win * 128 + i;
        const int jmax = (i < 64) ? 64 : 128;
        float acc[64];
#pragma unroll
        for (int c = 0; c < 64; ++c) acc[c] = 0.f;
        const float* wrow = wsp + ((size_t)g * 128 + i) * 128;
        for (int j = 0; j < jmax; ++j) { const float wv = wrow[j]; const v4u* vr = (const v4u*)(VN + (size_t)(win * 128 + j) * 512 + g * 64);
#pragma unroll
            for (int t = 0; t < 8; ++t) { const v4u w = vr[t]; float f[8]; UNPACK8(w, f);
#pragma unroll
                for (int e = 0; e < 8; ++e) acc[t * 8 + e] += wv * f[e]; } }
        const float bsv = bsp[g * 128 + i];
        const v4u* ur = (const v4u*)(Z + (size_t)tok * INW + g * 64); f32x4* yo = (f32x4*)(Yt + (size_t)tok * D_ + g * 64);
#pragma unroll
        for (int t = 0; t < 8; ++t) { const v4u w = ur[t]; float f[8]; UNPACK8(w, f);
            f32x4 a, b;
#pragma unroll
            for (int e = 0; e < 4; ++e) { a[e] = f[e] * (acc[t * 8 + e] + bsv); b[e] = f[4 + e] * (acc[t * 8 + 4 + e] + bsv); }
            yo[2 * t] = a; yo[2 * t + 1] = b; }
    }
}
__device__ __forceinline__ void naive_attn(const bf16* Z, const float* rel, float* Yt, int gtid, int NT) {
    for (int idx = gtid; idx < M_ * 8; idx += NT) {
        const int i = idx & 63, h = (idx >> 6) & 7, cgi = idx >> 9, c = cgi & 31, tok = cgi * 64 + i;
        float q[64], o[64];
        { const v4u* qr = (const v4u*)(Z + (size_t)tok * INW + 1024 + h * 64);
#pragma unroll
          for (int t = 0; t < 8; ++t) { const v4u w = qr[t]; float f[8]; UNPACK8(w, f);
#pragma unroll
              for (int e = 0; e < 8; ++e) { q[t * 8 + e] = f[e]; o[t * 8 + e] = 0.f; } } }
        float mrun = -1e30f, l = 0.f; const float* rt = rel + h * 513;
        for (int jt = 0; jt < 9; ++jt) { if (c - 8 + jt < 0) continue;
            const bf16* kbase = Z + (size_t)(cgi - 8 + jt) * 64 * INW + 1536 + h * 64;
            for (int kk = 0; kk < 64; ++kk) {
                const v4u* kr = (const v4u*)(kbase + (size_t)kk * INW); float s = 0.f;
#pragma unroll
                for (int t = 0; t < 8; ++t) { const v4u w = kr[t]; float f[8]; UNPACK8(w, f);
#pragma unroll
                    for (int e = 0; e < 8; ++e) s += q[t * 8 + e] * f[e]; }
                const int dist = i - kk + 64 * (8 - jt); const int bi = (dist > 256 ? 256 : dist) + 256;
                s = s * 0.125f + rt[bi];
                const float mn = fmaxf(mrun, s), corr = __expf(mrun - mn), pe = __expf(s - mn); l = l * corr + pe; mrun = mn;
                const v4u* vr = (const v4u*)(kbase + 512 + (size_t)kk * INW);
#pragma unroll
                for (int t = 0; t < 8; ++t) { const v4u w = vr[t]; float f[8]; UNPACK8(w, f);
#pragma unroll
                    for (int e = 0; e < 8; ++e) o[t * 8 + e] = o[t * 8 + e] * corr + pe * f[e]; } } }
        const float inv = 1.f / l; f32x4* yo = (f32x4*)(Yt + (size_t)tok * D_ + 512 + h * 64);
#pragma unroll
        for (int t = 0; t < 16; ++t) yo[t] = (f32x4){o[4 * t] * inv, o[4 * t + 1] * inv, o[4 * t + 2] * inv, o[4 * t + 3] * inv};
    }
}

__global__ void __launch_bounds__(512, 2) fwd_mega(Params p) {
    extern __shared__ __attribute__((aligned(16))) unsigned char lds_raw[];
    cg::grid_group grid = cg::this_grid();
    LAS unsigned char* lds = (LAS unsigned char*)lds_raw;
    const int tid = threadIdx.x, lane = tid & 63, wave = __builtin_amdgcn_readfirstlane(tid >> 6);
    const int G = gridDim.x, gtid = blockIdx.x * 512 + tid, NT = G * 512;
    unsigned char* ws = p.ws;
    bf16* XB = (bf16*)(ws + WS_XB); bf16* Z = (bf16*)(ws + WS_Z); bf16* Y = (bf16*)(ws + WS_Y); bf16* F = (bf16*)(ws + WS_F);
    float* H1 = (float*)(ws + WS_H1); bf16* H1B = (bf16*)(ws + WS_H1B);

    prologue(p, lds, tid, lane, wave);
    grid.sync();
    { pg8::Gemm g{XB, (const bf16*)(ws + WS_WIN), M_, INW, D_}; pg8::StaticOrder S; S.init(M_, INW, G, (int)blockIdx.x);
      pg8::EpiAct<1> E{Z, INW, 4};
      pg8::gemm_phase<pg8::EpiAct<1>, pg8::StaticOrder, true, true>(lds, g, S, E); }
    grid.sync();
    { float* Yt = (float*)(ws + WS_YT); bf16* VN = (bf16*)(ws + WS_VN);
      naive_vn(Z, p.in[2], p.in[3], VN, gtid, NT);
      grid.sync();
      naive_gmlp(Z, VN, p.in[4], p.in[5], Yt, gtid, NT);
      naive_attn(Z, p.in[6], Yt, gtid, NT);
      grid.sync();
      rms_rows(Yt, p.in[7], p.in[8], Y, lane, wave); }
    grid.sync();
    { pg8::Gemm g{Y, (const bf16*)(ws + WS_WOUT), M_, D_, D_}; pg8::StaticOrder S; S.init(M_, D_, G, (int)blockIdx.x);
      pg8::EpiRes E{p.in[0], H1, D_, ALPHA};
      pg8::gemm_phase<pg8::EpiRes, pg8::StaticOrder, true, true>(lds, g, S, E); }
    grid.sync();
    ln_rows(H1, p.in[10], p.in[11], H1, H1B, lane, wave);
    grid.sync();
    { pg8::Gemm g{H1B, (const bf16*)(ws + WS_W1), M_, FF_, D_}; pg8::StaticOrder S; S.init(M_, FF_, G, (int)blockIdx.x);
      pg8::EpiAct<2> E{F, FF_, 0};
      pg8::gemm_phase<pg8::EpiAct<2>, pg8::StaticOrder, true, true>(lds, g, S, E); }
    grid.sync();
    { pg8::Gemm g{F, (const bf16*)(ws + WS_W2), M_, D_, FF_}; pg8::StaticOrder S; S.init(M_, D_, G, (int)blockIdx.x);
      pg8::EpiRes E{H1, p.out, D_, ALPHA};
      pg8::gemm_phase<pg8::EpiRes, pg8::StaticOrder, true, true>(lds, g, S, E); }
    grid.sync();
    ln_rows(p.out, p.in[14], p.in[15], p.out, nullptr, lane, wave);
}

extern "C" void kernel_launch(void* const* d_in, const int* in_sizes, int n_in, void* d_out, int out_size, void* d_ws, size_t ws_size, hipStream_t stream) {
    static int grid = 0;
    if (grid == 0) {
        if (n_in != 16 || in_sizes[0] != M_ * D_ || out_size != M_ * D_ || ws_size < WS_END) { fprintf(stderr, "kernel_launch: unexpected shapes (n_in %d, in0 %d, out %d, ws %zu)\n", n_in, n_in > 0 ? in_sizes[0] : -1, out_size, ws_size); grid = -1; return; }
        int dev = 0, cus = 0, per_cu = 0;
        (void)hipGetDevice(&dev); (void)hipDeviceGetAttribute(&cus, hipDeviceAttributeMultiprocessorCount, dev);
        if (hipFuncSetAttribute((const void*)fwd_mega, hipFuncAttributeMaxDynamicSharedMemorySize, LDS_BYTES) != hipSuccess) { fprintf(stderr, "kernel_launch: hipFuncSetAttribute failed\n"); grid = -1; return; }
        if (hipOccupancyMaxActiveBlocksPerMultiprocessor(&per_cu, (const void*)fwd_mega, 512, LDS_BYTES) != hipSuccess || per_cu < 1) { fprintf(stderr, "kernel_launch: occupancy query says %d blocks per CU\n", per_cu); (void)hipGetLastError(); per_cu = 1; }
        grid = cus * (per_cu > 1 ? 1 : per_cu);
    }
    if (grid < 0) return;
    Params p{};
    for (int i = 0; i < 16; ++i) p.in[i] = (const float*)d_in[i];
    p.out = (float*)d_out; p.ws = (unsigned char*)d_ws;
    void* args[] = {&p};
    hipError_t e = hipLaunchCooperativeKernel((const void*)fwd_mega, dim3(grid), dim3(512), args, LDS_BYTES, stream);
    if (e != hipSuccess) fprintf(stderr, "kernel_launch: cooperative launch failed: %s (grid %d)\n", hipGetErrorString(e), grid);
}
```

```cpp
#include <hip/hip_runtime.h>
#include <hip/hip_cooperative_groups.h>
#include <cstdio>
#include <cstdint>
namespace cg = cooperative_groups;
__device__ __forceinline__ int lane_id_opaque() { int l; asm volatile("v_mbcnt_lo_u32_b32 %0, -1, 0\n\tv_mbcnt_hi_u32_b32 %0, -1, %0" : "=v"(l)); return l; }
namespace pg8 {
#define PG8_LAS __attribute__((address_space(3)))
typedef unsigned short bf16_t;
typedef short bf16x8 __attribute__((ext_vector_type(8)));
typedef float f32x4 __attribute__((ext_vector_type(4)));
typedef unsigned u32x4 __attribute__((ext_vector_type(4)));
constexpr int BM = 256, BK = 64, HALF = 128, HTB = HALF * BK * 2  , STAGE_BYTES = 8 * HTB, NXCD = 8, WGM = 8;

__host__ __device__ __forceinline__ int lds_byte(int r, int c) { const int st = (r >> 4) * 2 + (c >> 5), rr = r & 15, cc = c & 31, ob = rr * 64 + cc * 2; return st * 1024 + (ob ^ (((ob >> 9) & 1) << 5)); }
__host__ __device__ __forceinline__ void stage_rc(int b, int& R, int& C) { const int st = b / 1024, sb = b % 1024, swz = sb ^ (((sb >> 9) & 1) << 5); R = (st >> 1) * 16 + swz / 64; C = (st & 1) * 32 + (swz % 64) / 2; }
__host__ __device__ __forceinline__ int perm32(int rho) { const int n = rho >> 4, i = rho & 15; return 8 * (i >> 2) + 4 * n + (i & 3); }

struct Unit { int pm, pn; };
struct Gemm { const bf16_t* A; const bf16_t* Bt; int M, N, K; };

struct StaticOrder {
    int nM, nN, nwg, G, c;
    __host__ __device__ void init(int M, int N, int G_, int c_) { nM = M / BM; nN = N / BM; nwg = nM * nN; G = G_; c = c_; }
    __host__ __device__ bool next(int i, Unit& u) const {
        const long L = (long)i * G + c; if (L >= nwg) return false;
        int wgid = (int)L; { const int q = nwg / NXCD, r = nwg % NXCD, xcd = wgid % NXCD, off = wgid / NXCD; wgid = (xcd < r ? xcd * (q + 1) : r * (q + 1) + (xcd - r) * q) + off; }
        const int nig = WGM * nN, gid = wgid / nig, fm = gid * WGM, gsz = (nM - fm) < WGM ? (nM - fm) : WGM;
        u.pm = fm + ((wgid % nig) % gsz); u.pn = (wgid % nig) / gsz; return true;
    }
    __device__ __forceinline__ void a_ready(const Unit&) const {}
    __device__ __forceinline__ void done(const Unit&) const {}
};

__device__ __forceinline__ unsigned cvt_pk_bf16(float lo, float hi) { unsigned r; asm volatile("v_cvt_pk_bf16_f32 %0, %1, %2" : "=v"(r) : "v"(lo), "v"(hi)); return r; }
typedef float f32x2 __attribute__((ext_vector_type(2)));
__device__ __forceinline__ float gelu_tanh(float v) {
    const float u = v * (0.7978845608028654f + 0.035677408136300125f * v * v);
    const float e = __builtin_amdgcn_exp2f(-2.8853900817779268f * u);
    return v * __builtin_amdgcn_rcpf(1.0f + e);
}
template <int ACT> struct EpiAct {
    static constexpr bool PERM = true, AFTER_DRAIN = false;
    bf16_t* O; int ldc; int nact;
    __device__ __forceinline__ void operator()(const f32x4 (&acc)[2][2][4][2], const Unit& u, int wr, int wc, int fr, int fq) const {
        const int row0 = u.pm * BM + wr * 64 + fr; const int col0 = u.pn * BM + wc * 32 + 8 * fq;
        const bool act = (ACT == 1) && (u.pn < nact);
#pragma unroll
        for (int ai = 0; ai < 2; ++ai)
#pragma unroll
            for (int m = 0; m < 4; ++m) { bf16_t* rowp = O + (size_t)(row0 + ai * HALF + m * 16) * ldc + col0;
#pragma unroll
                for (int bj = 0; bj < 2; ++bj) { f32x4 v0 = acc[ai][bj][m][0], v1 = acc[ai][bj][m][1];
                    if (ACT == 1) { if (act) {
#pragma unroll
                        for (int e = 0; e < 4; ++e) { v0[e] = gelu_tanh(v0[e]); v1[e] = gelu_tanh(v1[e]); } } }
                    if (ACT == 2) {
#pragma unroll
                        for (int e = 0; e < 4; ++e) { const float a = fmaxf(v0[e], 0.f), b = fmaxf(v1[e], 0.f); v0[e] = a * a; v1[e] = b * b; } }
                    u32x4 w; w.x = cvt_pk_bf16(v0[0], v0[1]); w.y = cvt_pk_bf16(v0[2], v0[3]); w.z = cvt_pk_bf16(v1[0], v1[1]); w.w = cvt_pk_bf16(v1[2], v1[3]);
                    *(u32x4*)(rowp + bj * HALF) = w; } }
    }
};
struct EpiRes {
    static constexpr bool PERM = false, AFTER_DRAIN = false;
    const float* res; float* out; int ldc; float alpha;
    __device__ __forceinline__ void operator()(const f32x4 (&acc)[2][2][4][2], const Unit& u, int wr, int wc, int fr, int fq) const {
        const int col0 = u.pn * BM + wc * 32 + 4 * fq;
#pragma unroll
        for (int ai = 0; ai < 2; ++ai)
#pragma unroll
            for (int m = 0; m < 4; ++m) { const int r = u.pm * BM + ai * HALF + wr * 64 + m * 16 + fr; const size_t off = (size_t)r * ldc + col0;
#pragma unroll
                for (int bj = 0; bj < 2; ++bj)
#pragma unroll
                    for (int n = 0; n < 2; ++n) { const f32x4 bs = *(const f32x4*)(res + off + bj * HALF + n * 16); const f32x4 o = bs * alpha + acc[ai][bj][m][n];
                        *(f32x4*)(out + off + bj * HALF + n * 16) = o; }
                if (m & 1) asm volatile("" ::: "memory"); }
    }
};

template <class Epi, class Sched, bool ALIGN_EPI = false, bool SP2 = false>
__device__ __forceinline__ void gemm_phase(PG8_LAS unsigned char* lds, const Gemm g, const Sched& S, const Epi& E, const int wave_in) {
    const int tid_ = wave_in * 64 + lane_id_opaque();
    const int tid = tid_, wid = __builtin_amdgcn_readfirstlane(tid >> 6), lane = tid & 63, wr = wid >> 2, wc = wid & 3, fr = lane & 15, fq = lane >> 4;
    const int K = g.K, nt = K / BK;
    unsigned voffA[2], voffB[2];
#pragma unroll
    for (int i = 0; i < 2; ++i) { int R, C; stage_rc(tid * 16 + i * 8192, R, C); const int Rb = Epi::PERM ? ((R & ~31) + perm32(R & 31)) : R;
        voffA[i] = (unsigned)(R * K + C) * 2u; voffB[i] = (unsigned)(Rb * K + C) * 2u; }
    const size_t kstep = (size_t)(BK * 2);
    const size_t hstep = (size_t)HALF * K * 2;
    const size_t tstep = 2 * hstep;
    const unsigned ldsw = (unsigned)wid * 1024u;
    const int aoff = lds_byte(wr * 64 + fr, fq * 8), boff = lds_byte(wc * 32 + fr, fq * 8);
#define PG8_SA(b, h) (((b) * 2 + (h)) * HTB)
#define PG8_SB(b, h) ((4 + (b) * 2 + (h)) * HTB)
#define PG8_STAGE(bufoff, gbase, voff) do { _Pragma("unroll") for (int _i = 0; _i < 2; ++_i) \
        __builtin_amdgcn_global_load_lds((const unsigned*)((const char*)(gbase) + (voff)[_i]), (PG8_LAS unsigned*)(lds + (bufoff) + ldsw + _i * 8192), 16, 0, 0); } while (0)
#define PG8_LDA(dst, b, h) do { _Pragma("unroll") for (int m = 0; m < 4; ++m) _Pragma("unroll") for (int k = 0; k < 2; ++k) dst[m][k] = *(const PG8_LAS bf16x8*)(lds + PG8_SA(b, h) + aoff + m * 2048 + k * 1024); } while (0)
#define PG8_LDB(dst, b, h) do { _Pragma("unroll") for (int n = 0; n < 2; ++n) _Pragma("unroll") for (int k = 0; k < 2; ++k) dst[n][k] = *(const PG8_LAS bf16x8*)(lds + PG8_SB(b, h) + boff + n * 2048 + k * 1024); } while (0)
#define PG8_MMA(ai, bj, At, Bt) do { __builtin_amdgcn_s_setprio(1); _Pragma("unroll") for (int m = 0; m < 4; ++m) _Pragma("unroll") for (int n = 0; n < 2; ++n) _Pragma("unroll") for (int k = 0; k < 2; ++k) \
        acc[ai][bj][m][n] = __builtin_amdgcn_mfma_f32_16x16x32_bf16(Bt[n][k], At[m][k], acc[ai][bj][m][n], 0, 0, 0); __builtin_amdgcn_s_setprio(0); } while (0)
#define PG8_WAIT_V(n) asm volatile("s_waitcnt vmcnt(" #n ")" ::: "memory")
#define PG8_WAIT_L(n) asm volatile("s_waitcnt lgkmcnt(" #n ")" ::: "memory")
#define PG8_BAR __builtin_amdgcn_s_barrier()
#define PG8_SCHED __builtin_amdgcn_sched_barrier(0)
    Unit cur, nxt; int ui = 0;
    if (!S.next(0, cur)) return;
    f32x4 acc[2][2][4][2];
#pragma unroll
    for (int a = 0; a < 2; ++a)
#pragma unroll
        for (int b = 0; b < 2; ++b)
#pragma unroll
            for (int m = 0; m < 4; ++m)
#pragma unroll
                for (int n = 0; n < 2; ++n) acc[a][b][m][n] = (f32x4){0.f, 0.f, 0.f, 0.f};
    bf16x8 At[4][2], B0[2][2], B1[2][2];
    const char* cA = (const char*)g.A + (size_t)cur.pm * tstep; const char* cB = (const char*)g.Bt + (size_t)cur.pn * tstep;
    S.a_ready(cur);
    if constexpr (SP2) {
        PG8_STAGE(PG8_SB(0, 0), cB, voffB); PG8_STAGE(PG8_SB(0, 1), cB + hstep, voffB); PG8_STAGE(PG8_SA(0, 0), cA, voffA); PG8_STAGE(PG8_SA(0, 1), cA + hstep, voffA);
        if (wr == 1) PG8_BAR;
        PG8_WAIT_V(2); PG8_BAR;
        PG8_STAGE(PG8_SB(1, 0), cB + kstep, voffB); PG8_STAGE(PG8_SA(1, 0), cA + kstep, voffA); PG8_STAGE(PG8_SB(1, 1), cB + hstep + kstep, voffB);
        PG8_WAIT_V(6); PG8_BAR;
    } else {
        PG8_STAGE(PG8_SB(0, 0), cB, voffB); PG8_STAGE(PG8_SA(0, 0), cA, voffA); PG8_STAGE(PG8_SB(0, 1), cB + hstep, voffB); PG8_STAGE(PG8_SA(0, 1), cA + hstep, voffA);
        if (wr == 1) PG8_BAR;
        PG8_WAIT_V(4); PG8_BAR;
        PG8_STAGE(PG8_SB(1, 0), cB + kstep, voffB); PG8_STAGE(PG8_SA(1, 0), cA + kstep, voffA); PG8_STAGE(PG8_SB(1, 1), cB + hstep + kstep, voffB);
        PG8_WAIT_V(6); PG8_BAR;
    }
    for (;;) {
        const bool has_next = S.next(ui + 1, nxt);
        const char* nA = has_next ? (const char*)g.A + (size_t)nxt.pm * tstep : cA; const char* nB = has_next ? (const char*)g.Bt + (size_t)nxt.pn * tstep : cB;
        for (int t = 0; t < nt; t += 2) {
            const bool last = (t == nt - 2);
            const char* a1 = cA + (size_t)(t + 1) * kstep;
            const char* a2 = last ? nA : cA + (size_t)(t + 2) * kstep; const char* b2 = last ? nB : cB + (size_t)(t + 2) * kstep;
            const char* a3 = a2 + kstep; const char* b3 = b2 + kstep;
            if (last && has_next) S.a_ready(nxt);
            if constexpr (SP2) {
            PG8_LDB(B0, 0, 0); PG8_LDB(B1, 0, 1); PG8_SCHED; PG8_LDA(At, 0, 0); PG8_STAGE(PG8_SA(1, 1), a1 + hstep, voffA);
            PG8_WAIT_V(8); PG8_WAIT_L(0); PG8_BAR; PG8_MMA(0, 0, At, B0); PG8_MMA(0, 1, At, B1); PG8_BAR; PG8_SCHED;
            PG8_LDA(At, 0, 1); PG8_STAGE(PG8_SB(0, 0), b2, voffB); PG8_STAGE(PG8_SB(0, 1), b2 + hstep, voffB); PG8_STAGE(PG8_SA(0, 0), a2, voffA);
            PG8_WAIT_V(8); PG8_WAIT_L(0); PG8_BAR; PG8_MMA(1, 0, At, B0); PG8_MMA(1, 1, At, B1); PG8_BAR; PG8_SCHED;
            PG8_LDB(B0, 1, 0); PG8_LDB(B1, 1, 1); PG8_SCHED; PG8_LDA(At, 1, 0); PG8_STAGE(PG8_SA(0, 1), a2 + hstep, voffA);
            PG8_WAIT_V(8); PG8_WAIT_L(0); PG8_BAR; PG8_MMA(0, 0, At, B0); PG8_MMA(0, 1, At, B1); PG8_BAR; PG8_SCHED;
            PG8_LDA(At, 1, 1); PG8_STAGE(PG8_SB(1, 0), b3, voffB); PG8_STAGE(PG8_SB(1, 1), b3 + hstep, voffB); PG8_STAGE(PG8_SA(1, 0), a3, voffA);
            PG8_WAIT_V(8); PG8_WAIT_L(0); PG8_BAR; PG8_MMA(1, 0, At, B0); PG8_MMA(1, 1, At, B1); PG8_BAR; PG8_SCHED;
            } else {
            PG8_LDB(B0, 0, 0); PG8_SCHED; PG8_LDA(At, 0, 0); PG8_STAGE(PG8_SA(1, 1), a1 + hstep, voffA);
            PG8_WAIT_L(8); PG8_BAR; PG8_WAIT_L(0); PG8_MMA(0, 0, At, B0); PG8_BAR; PG8_SCHED;
            PG8_LDB(B1, 0, 1); PG8_STAGE(PG8_SB(0, 0), b2, voffB);
            PG8_BAR; PG8_WAIT_L(0); PG8_MMA(0, 1, At, B1); PG8_BAR;
            PG8_LDA(At, 0, 1); PG8_STAGE(PG8_SA(0, 0), a2, voffA);
            PG8_BAR; PG8_WAIT_L(0); PG8_MMA(1, 0, At, B0); PG8_BAR; PG8_SCHED;
            PG8_STAGE(PG8_SB(0, 1), b2 + hstep, voffB);
            PG8_WAIT_V(6); PG8_BAR; PG8_MMA(1, 1, At, B1); PG8_BAR;
            PG8_LDB(B0, 1, 0); PG8_SCHED; PG8_LDA(At, 1, 0); PG8_STAGE(PG8_SA(0, 1), a2 + hstep, voffA);
            PG8_WAIT_L(8); PG8_BAR; PG8_WAIT_L(0); PG8_MMA(0, 0, At, B0); PG8_BAR; PG8_SCHED;
            PG8_LDB(B1, 1, 1); PG8_STAGE(PG8_SB(1, 0), b3, voffB);
            PG8_BAR; PG8_WAIT_L(0); PG8_MMA(0, 1, At, B1); PG8_BAR;
            PG8_LDA(At, 1, 1); PG8_STAGE(PG8_SA(1, 0), a3, voffA);
            PG8_BAR; PG8_WAIT_L(0); PG8_MMA(1, 0, At, B0); PG8_BAR; PG8_SCHED;
            PG8_STAGE(PG8_SB(1, 1), b3 + hstep, voffB);
            PG8_WAIT_V(6); PG8_BAR; PG8_MMA(1, 1, At, B1); PG8_BAR;
            }
        }
        if constexpr (ALIGN_EPI) { if (wr == 0) PG8_BAR; }
        if constexpr (!Epi::AFTER_DRAIN) { E(acc, cur, wr, wc, fr, fq); S.done(cur); }
        if (!has_next) break;
#pragma unroll
        for (int a = 0; a < 2; ++a)
#pragma unroll
            for (int b = 0; b < 2; ++b)
#pragma unroll
                for (int m = 0; m < 4; ++m)
#pragma unroll
                    for (int n = 0; n < 2; ++n) acc[a][b][m][n] = (f32x4){0.f, 0.f, 0.f, 0.f};
        cur = nxt; cA = nA; cB = nB; ++ui;
        if constexpr (ALIGN_EPI) { if (wr == 1) PG8_BAR; }
    }
    PG8_WAIT_V(0);
    if constexpr (!ALIGN_EPI) { if (wr == 0) PG8_BAR; }
    PG8_BAR;
    if constexpr (Epi::AFTER_DRAIN) { E.fused(acc, cur, wr, wc, fr, fq, lds, wid, lane); S.done(cur); }
#undef PG8_SA
#undef PG8_SB
#undef PG8_STAGE
#undef PG8_LDA
#undef PG8_LDB
#undef PG8_MMA
#undef PG8_WAIT_V
#undef PG8_WAIT_L
#undef PG8_BAR
#undef PG8_SCHED
}
}
constexpr int M_ = 65536, D_ = 1024, INW = 2560, FF_ = 4096;
constexpr float ALPHA = 1.189207115002721f;
constexpr size_t MiB = 1u << 20;
constexpr size_t WS_WIN = 2 * MiB, WS_WOUT = 8 * MiB, WS_W1 = 10 * MiB, WS_W2 = 18 * MiB, WS_WSM = 26 * MiB;
constexpr size_t WS_XB = 32 * MiB;
constexpr size_t WS_Z = 160 * MiB;
constexpr size_t WS_Y = 480 * MiB;
constexpr size_t WS_F = 32 * MiB;
constexpr size_t WS_H1 = 608 * MiB;
constexpr size_t WS_H1B = 864 * MiB;
constexpr size_t WS_END = 992 * MiB;
constexpr size_t WS_YT = WS_H1;
constexpr size_t WS_VN = WS_H1B;
constexpr int LDS_BYTES = 155648;
#ifndef MIX_NAIVE
#define MIX_NAIVE 0
#endif

#define LAS __attribute__((address_space(3)))
typedef unsigned short bf16;
typedef unsigned v4u __attribute__((ext_vector_type(4)));
typedef unsigned v2u __attribute__((ext_vector_type(2)));
typedef float f32x4 __attribute__((ext_vector_type(4)));
typedef float f32x2_t __attribute__((ext_vector_type(2)));
typedef __bf16 bf16x2_t __attribute__((ext_vector_type(2)));
__device__ __forceinline__ unsigned pkbf(float lo, float hi) { f32x2_t v = {lo, hi}; bf16x2_t b = __builtin_convertvector(v, bf16x2_t); return __builtin_bit_cast(unsigned, b); }
__device__ __forceinline__ float bflo(unsigned w) { return __uint_as_float(w << 16); }
__device__ __forceinline__ float bfhi(unsigned w) { return __uint_as_float(w & 0xffff0000u); }
__device__ __forceinline__ float wave_sum(float v) {
#pragma unroll
    for (int o = 1; o < 64; o <<= 1) v += __shfl_xor(v, o);
    return v;
}

struct Params { const float* in[16]; float* out; unsigned char* ws; };

__device__ __forceinline__ void transpose_item(const float* W, int K, int N, bf16* WT, LAS float* scr, int item, int lane) {
    const int nblk = N / 32, kb = item / nblk, nb = item % nblk, k0 = 64 * kb, n0 = 32 * nb;
#pragma unroll 8
    for (int i = 0; i < 32; ++i) { const int kk = 2 * i + (lane >> 5); scr[kk * 33 + (lane & 31)] = W[(size_t)(k0 + kk) * N + n0 + (lane & 31)]; }
    asm volatile("s_waitcnt lgkmcnt(0)" ::: "memory");
    const int c = lane & 7;
#pragma unroll
    for (int j = 0; j < 4; ++j) { const int n = (lane >> 3) + 8 * j; const LAS float* s = scr + (8 * c) * 33 + n;
        v4u o; o.x = pkbf(s[0 * 33], s[1 * 33]); o.y = pkbf(s[2 * 33], s[3 * 33]); o.z = pkbf(s[4 * 33], s[5 * 33]); o.w = pkbf(s[6 * 33], s[7 * 33]);
        *(v4u*)(WT + (size_t)(n0 + n) * K + k0 + 8 * c) = o; }
    asm volatile("s_waitcnt lgkmcnt(0)" ::: "memory");
}
__device__ __forceinline__ void prologue(const Params& p, LAS unsigned char* lds, int wave) {
    const int lane = lane_id_opaque(), tid = wave * 64 + lane;
    unsigned char* ws = p.ws;
    LAS float* scr = (LAS float*)(lds + wave * 16384);
    const int gw = blockIdx.x * 8 + wave, NGW = gridDim.x * 8;
    constexpr int I_IN = (D_ / 64) * (INW / 32), I_O = (D_ / 64) * (D_ / 32), I_1 = (D_ / 64) * (FF_ / 32), I_2 = (FF_ / 64) * (D_ / 32);
    constexpr int NITEMS = I_IN + I_O + I_1 + I_2;
    for (int it = gw; it < NITEMS; it += NGW) {
        int r = it;
        if (r < I_IN) { transpose_item(p.in[1], D_, INW, (bf16*)(ws + WS_WIN), scr, r, lane); continue; } r -= I_IN;
        if (r < I_O) { transpose_item(p.in[9], D_, D_, (bf16*)(ws + WS_WOUT), scr, r, lane); continue; } r -= I_O;
        if (r < I_1) { transpose_item(p.in[12], D_, FF_, (bf16*)(ws + WS_W1), scr, r, lane); continue; } r -= I_1;
        transpose_item(p.in[13], FF_, D_, (bf16*)(ws + WS_W2), scr, r, lane);
    }
    const int gtid = blockIdx.x * 512 + tid, NT = gridDim.x * 512;
    { const float* wsp = p.in[4]; bf16* wsm = (bf16*)(ws + WS_WSM);
      for (int v = gtid; v < 8 * 128 * 128 / 8; v += NT) { const int e = v * 8, i = (e >> 7) & 127, j = e & 127; const bool z = (i < 64) && (j >= 64);
          const f32x4 a = *(const f32x4*)(wsp + e), b = *(const f32x4*)(wsp + e + 4);
          v4u o; o.x = pkbf(a[0], a[1]); o.y = pkbf(a[2], a[3]); o.z = pkbf(b[0], b[1]); o.w = pkbf(b[2], b[3]); if (z) o = (v4u){0u, 0u, 0u, 0u};
          *(v4u*)(wsm + e) = o; } }
    { const f32x4* x4 = (const f32x4*)p.in[0]; v4u* xb = (v4u*)(ws + WS_XB);
      for (size_t v = (size_t)gtid; v < (size_t)M_ * D_ / 8; v += (size_t)NT) { const f32x4 a = x4[2 * v], b = x4[2 * v + 1];
          v4u o; o.x = pkbf(a[0], a[1]); o.y = pkbf(a[2], a[3]); o.z = pkbf(b[0], b[1]); o.w = pkbf(b[2], b[3]); xb[v] = o; } }
}

__device__ __forceinline__ void ln_rows(const float* T, const float* g, const float* b, float* outf, bf16* outb, int wave) {
    const int lane = lane_id_opaque();
    const int gw = blockIdx.x * 8 + wave, NGW = gridDim.x * 8;
    f32x4 gv[4], bv[4];
#pragma unroll
    for (int j = 0; j < 4; ++j) { gv[j] = ((const f32x4*)g)[lane + 64 * j]; bv[j] = ((const f32x4*)b)[lane + 64 * j]; }
    for (int r = gw; r < M_; r += NGW) {
        const f32x4* tr = (const f32x4*)(T + (size_t)r * D_) + lane;
        f32x4 v[4]; float s = 0.f;
#pragma unroll
        for (int j = 0; j < 4; ++j) { v[j] = tr[64 * j]; s += (v[j][0] + v[j][1]) + (v[j][2] + v[j][3]); }
        const float mean = wave_sum(s) * (1.f / D_); float s2 = 0.f;
#pragma unroll
        for (int j = 0; j < 4; ++j) { v[j] = v[j] - mean; s2 += (v[j][0] * v[j][0] + v[j][1] * v[j][1]) + (v[j][2] * v[j][2] + v[j][3] * v[j][3]); }
        const float rstd = 1.f / sqrtf(wave_sum(s2) * (1.f / D_) + 1e-5f);
#pragma unroll
        for (int j = 0; j < 4; ++j) { const f32x4 o = v[j] * rstd * gv[j] + bv[j];
            if (outf) ((f32x4*)(outf + (size_t)r * D_))[lane + 64 * j] = o;
            if (outb) { v2u w; w.x = pkbf(o[0], o[1]); w.y = pkbf(o[2], o[3]); ((v2u*)(outb + (size_t)r * D_))[lane + 64 * j] = w; } }
    }
}
__device__ __forceinline__ void rms_rows(const float* Yt, const float* gA, const float* gB, bf16* Y, int wave) {
    const int lane = lane_id_opaque();
    const int gw = blockIdx.x * 8 + wave, NGW = gridDim.x * 8;
    f32x4 gv[4];
#pragma unroll
    for (int j = 0; j < 2; ++j) { gv[j] = ((const f32x4*)gA)[lane + 64 * j]; gv[2 + j] = ((const f32x4*)gB)[lane + 64 * j]; }
    for (int r = gw; r < M_; r += NGW) {
        const f32x4* tr = (const f32x4*)(Yt + (size_t)r * D_) + lane;
        f32x4 v[4]; float sq[4];
#pragma unroll
        for (int j = 0; j < 4; ++j) { v[j] = tr[64 * j]; sq[j] = (v[j][0] * v[j][0] + v[j][1] * v[j][1]) + (v[j][2] * v[j][2] + v[j][3] * v[j][3]); }
        const float rA = 1.f / sqrtf(wave_sum(sq[0] + sq[1]) * (1.f / 512.f) + 1e-6f), rB = 1.f / sqrtf(wave_sum(sq[2] + sq[3]) * (1.f / 512.f) + 1e-6f);
#pragma unroll
        for (int j = 0; j < 4; ++j) { const f32x4 o = v[j] * (j < 2 ? rA : rB) * gv[j];
            v2u w; w.x = pkbf(o[0], o[1]); w.y = pkbf(o[2], o[3]); ((v2u*)(Y + (size_t)r * D_))[lane + 64 * j] = w; }
    }
}

#define UNPACK8(w, f) do { f[0] = bflo(w.x); f[1] = bfhi(w.x); f[2] = bflo(w.y); f[3] = bfhi(w.y); f[4] = bflo(w.z); f[5] = bfhi(w.z); f[6] = bflo(w.w); f[7] = bfhi(w.w); } while (0)
__device__ __forceinline__ void naive_vn(const bf16* Z, const float* lg, const float* lb, bf16* VN, int gtid, int NT) {
    for (int idx = gtid; idx < M_ * 8; idx += NT) {
        const int tok = idx >> 3, g = idx & 7;
        const v4u* zr = (const v4u*)(Z + (size_t)tok * INW + 512 + g * 64);
        float v[64]; float s = 0.f;
#pragma unroll
        for (int t = 0; t < 8; ++t) { const v4u w = zr[t]; float f[8]; UNPACK8(w, f);
#pragma unroll
            for (int e = 0; e < 8; ++e) { v[t * 8 + e] = f[e]; s += f[e]; } }
        const float mean = s * (1.f / 64.f); float s2 = 0.f;
#pragma unroll
        for (int c = 0; c < 64; ++c) { v[c] -= mean; s2 += v[c] * v[c]; }
        const float rstd = 1.f / sqrtf(s2 * (1.f / 64.f) + 1e-5f);
        v4u* o = (v4u*)(VN + (size_t)tok * 512 + g * 64);
#pragma unroll
        for (int t = 0; t < 8; ++t) { float y[8];
#pragma unroll
            for (int e = 0; e < 8; ++e) { const int c = t * 8 + e; y[e] = v[c] * rstd * lg[g * 64 + c] + lb[g * 64 + c]; }
            v4u w; w.x = pkbf(y[0], y[1]); w.y = pkbf(y[2], y[3]); w.z = pkbf(y[4], y[5]); w.w = pkbf(y[6], y[7]); o[t] = w; }
    }
}
__device__ __forceinline__ void naive_gmlp(const bf16* Z, const bf16* VN, const float* wsp, const float* bsp, float* Yt, int gtid, int NT) {
    for (int idx = gtid; idx < M_ * 8; idx += NT) {
        const int i = idx & 127, g = (idx >> 7) & 7, win = idx >> 10, tok = win * 128 + i;
        const int jmax = (i < 64) ? 64 : 128;
        float acc[64];
#pragma unroll
        for (int c = 0; c < 64; ++c) acc[c] = 0.f;
        const float* wrow = wsp + ((size_t)g * 128 + i) * 128;
        for (int j = 0; j < jmax; ++j) { const float wv = wrow[j]; const v4u* vr = (const v4u*)(VN + (size_t)(win * 128 + j) * 512 + g * 64);
#pragma unroll
            for (int t = 0; t < 8; ++t) { const v4u w = vr[t]; float f[8]; UNPACK8(w, f);
#pragma unroll
                for (int e = 0; e < 8; ++e) acc[t * 8 + e] += wv * f[e]; } }
        const float bsv = bsp[g * 128 + i];
        const v4u* ur = (const v4u*)(Z + (size_t)tok * INW + g * 64); f32x4* yo = (f32x4*)(Yt + (size_t)tok * D_ + g * 64);
#pragma unroll
        for (int t = 0; t < 8; ++t) { const v4u w = ur[t]; float f[8]; UNPACK8(w, f);
            f32x4 a, b;
#pragma unroll
            for (int e = 0; e < 4; ++e) { a[e] = f[e] * (acc[t * 8 + e] + bsv); b[e] = f[4 + e] * (acc[t * 8 + 4 + e] + bsv); }
            yo[2 * t] = a; yo[2 * t + 1] = b; }
    }
}
__device__ __forceinline__ void naive_attn(const bf16* Z, const float* rel, float* Yt, int gtid, int NT) {
    for (int idx = gtid; idx < M_ * 8; idx += NT) {
        const int i = idx & 63, h = (idx >> 6) & 7, cgi = idx >> 9, c = cgi & 31, tok = cgi * 64 + i;
        float q[64], o[64];
        { const v4u* qr = (const v4u*)(Z + (size_t)tok * INW + 1024 + h * 64);
#pragma unroll
          for (int t = 0; t < 8; ++t) { const v4u w = qr[t]; float f[8]; UNPACK8(w, f);
#pragma unroll
              for (int e = 0; e < 8; ++e) { q[t * 8 + e] = f[e]; o[t * 8 + e] = 0.f; } } }
        float mrun = -1e30f, l = 0.f; const float* rt = rel + h * 513;
        for (int jt = 0; jt < 9; ++jt) { if (c - 8 + jt < 0) continue;
            const bf16* kbase = Z + (size_t)(cgi - 8 + jt) * 64 * INW + 1536 + h * 64;
            for (int kk = 0; kk < 64; ++kk) {
                const v4u* kr = (const v4u*)(kbase + (size_t)kk * INW); float s = 0.f;
#pragma unroll
                for (int t = 0; t < 8; ++t) { const v4u w = kr[t]; float f[8]; UNPACK8(w, f);
#pragma unroll
                    for (int e = 0; e < 8; ++e) s += q[t * 8 + e] * f[e]; }
                const int dist = i - kk + 64 * (8 - jt); const int bi = (dist > 256 ? 256 : dist) + 256;
                s = s * 0.125f + rt[bi];
                const float mn = fmaxf(mrun, s), corr = __expf(mrun - mn), pe = __expf(s - mn); l = l * corr + pe; mrun = mn;
                const v4u* vr = (const v4u*)(kbase + 512 + (size_t)kk * INW);
#pragma unroll
                for (int t = 0; t < 8; ++t) { const v4u w = vr[t]; float f[8]; UNPACK8(w, f);
#pragma unroll
                    for (int e = 0; e < 8; ++e) o[t * 8 + e] = o[t * 8 + e] * corr + pe * f[e]; } } }
        const float inv = 1.f / l; f32x4* yo = (f32x4*)(Yt + (size_t)tok * D_ + 512 + h * 64);
#pragma unroll
        for (int t = 0; t < 16; ++t) yo[t] = (f32x4){o[4 * t] * inv, o[4 * t + 1] * inv, o[4 * t + 2] * inv, o[4 * t + 3] * inv};
    }
}


#define GAS __attribute__((address_space(1)))
typedef short bf16x8 __attribute__((ext_vector_type(8)));
typedef short s16x4 __attribute__((ext_vector_type(4)));
typedef float f32x16 __attribute__((ext_vector_type(16)));
#define MFMA32(a, b, c) __builtin_amdgcn_mfma_f32_32x32x16_bf16((a), (b), (c), 0, 0, 0)
constexpr int MX_TB = 131072, MX_SSQA = MX_TB + 10240, MX_SSQG = MX_SSQA + 4096;
static_assert(MX_SSQG + 8192 <= LDS_BYTES, "mixer LDS map");
__device__ __forceinline__ s16x4 trread(LAS unsigned char* p) { return __builtin_bit_cast(s16x4, __builtin_amdgcn_ds_read_tr16_b64_v4i16((LAS s16x4*)p)); }
__device__ __forceinline__ int swz(int row, int c16) { return row * 128 + ((c16 ^ ((row >> 1) & 7)) << 4); }
__device__ __forceinline__ void dma_tile(const bf16* g, LAS unsigned char* ldst, unsigned vo0, unsigned vo1) {
#pragma unroll
    for (int i = 0; i < 8; ++i) { const char* gb = (const char*)g + (size_t)i * (8 * INW * 2);
        __builtin_amdgcn_global_load_lds((const unsigned*)(gb + ((i & 1) ? vo1 : vo0)), (LAS unsigned*)(ldst + i * 1024), 16, 0, 0); }
}
__device__ __forceinline__ unsigned dma_voff(int lane, int odd) { const int rl = lane >> 3, cp = lane & 7; return (unsigned)(rl * (INW * 2) + (((cp ^ (rl >> 1)) ^ (odd ? 4 : 0)) << 4)); }
#define VM_WAIT(n) asm volatile("s_waitcnt vmcnt(" #n ")" ::: "memory")
#define LG_WAIT() asm volatile("s_waitcnt lgkmcnt(0)" ::: "memory")

__device__ __forceinline__ void attn_phase(const bf16* Z, const float* rel, const float* gateB, bf16* Y, LAS unsigned char* lds, int lane, int wave) {
    lane = lane_id_opaque();
    const int r = lane & 31, h = lane >> 5, hd = wave;
    LAS unsigned char* Kt = lds + wave * 16384; LAS unsigned char* Vt = Kt + 8192;
    LAS float* tb = (LAS float*)(lds + MX_TB + hd * 1280);
    LAS float* ssq = (LAS float*)(lds + MX_SSQA);
    for (int e = lane; e < 320; e += 64) tb[e] = rel[hd * 513 + 193 + e] * 1.4426950408889634f;
    const int q4 = (lane & 15) >> 2, p4 = lane & 3, blk = (lane >> 4) & 1;
    const bf16* Kg = Z + 1536 + hd * 64; const bf16* Vg = Z + 2048 + hd * 64;
    const unsigned vo0 = dma_voff(lane, 0), vo1 = dma_voff(lane, 1);
    int ucount = 0;
    for (int u = blockIdx.x; u < M_ / 64; u += gridDim.x, ++ucount) {
        const int c = u & 31, jt0 = (c >= 8) ? 0 : 8 - c; const size_t tok0 = (size_t)u * 64;
        dma_tile(Kg + (size_t)(u - 8 + jt0) * 64 * INW, Kt, vo0, vo1);
        dma_tile(Vg + (size_t)(u - 8 + jt0) * 64 * INW, Vt, vo0, vo1);
        bf16x8 qf[2][4];
#pragma unroll
        for (int bq = 0; bq < 2; ++bq)
#pragma unroll
            for (int s = 0; s < 4; ++s) qf[bq][s] = *(const bf16x8*)((const char*)(Z + tok0 * INW + 1024 + hd * 64) + (size_t)(bq * 32 * INW * 2 + s * 32) + (unsigned)(r * (INW * 2) + h * 16));
#pragma unroll
        for (int bq = 0; bq < 2; ++bq)
#pragma unroll
            for (int s = 0; s < 4; ++s) asm volatile("" : "+v"(qf[bq][s]));
        VM_WAIT(0);
        f32x16 O[2][2]; float m[2], l[2];
#pragma unroll
        for (int a = 0; a < 2; ++a) { m[a] = -1e30f; l[a] = 0.f;
#pragma unroll
            for (int b = 0; b < 2; ++b)
#pragma unroll
                for (int i = 0; i < 16; ++i) O[a][b][i] = 0.f; }
        for (int jt = jt0; jt < 9; ++jt) {
            const bool has_next = jt < 8;
            VM_WAIT(8);
            const float cs = 0.125f * 1.4426950408889634f;
#pragma unroll
            for (int bq = 0; bq < 2; ++bq) {
                f32x16 S[2];
#pragma unroll
                for (int a = 0; a < 2; ++a)
#pragma unroll
                    for (int i = 0; i < 16; ++i) S[a][i] = 0.f;
#pragma unroll
                for (int s = 0; s < 4; ++s)
#pragma unroll
                    for (int bk = 0; bk < 2; ++bk) { const bf16x8 kf = *(LAS bf16x8*)(Kt + swz(32 * bk + r, 2 * s + h)); S[bk] = MFMA32(kf, qf[bq][s], S[bk]); }
                if (bq == 1) { LG_WAIT(); if (has_next) dma_tile(Kg + (size_t)(u - 8 + jt + 1) * 64 * INW, Kt, vo0, vo1); }
                if (jt <= 3) { const float cb = tb[319];
#pragma unroll
                    for (int bk = 0; bk < 2; ++bk)
#pragma unroll
                        for (int i = 0; i < 16; ++i) S[bk][i] = S[bk][i] * cs + cb;
                } else { const int d0 = 32 * bq + r - 4 * h + 64 * (8 - jt) + 63;
                    if (jt == 4) {
#pragma unroll
                        for (int bk = 0; bk < 2; ++bk)
#pragma unroll
                            for (int i = 0; i < 16; ++i) { int ix = d0 - 32 * bk - ((i & 3) + 8 * (i >> 2)); ix = ix > 319 ? 319 : ix; S[bk][i] = S[bk][i] * cs + tb[ix]; }
                    } else {
#pragma unroll
                        for (int bk = 0; bk < 2; ++bk)
#pragma unroll
                            for (int i = 0; i < 16; ++i) { const int ix = d0 - 32 * bk - ((i & 3) + 8 * (i >> 2)); S[bk][i] = S[bk][i] * cs + tb[ix]; }
                    } }
                float mx = S[0][0];
#pragma unroll
                for (int bk = 0; bk < 2; ++bk)
#pragma unroll
                    for (int i = 0; i < 16; ++i) mx = fmaxf(mx, S[bk][i]);
                mx = fmaxf(mx, __shfl_xor(mx, 32));
                const float mnew = fmaxf(m[bq], mx), alpha = __builtin_amdgcn_exp2f(m[bq] - mnew); m[bq] = mnew;
                float ps = 0.f;
#pragma unroll
                for (int bk = 0; bk < 2; ++bk)
#pragma unroll
                    for (int i = 0; i < 16; ++i) { const float pe = __builtin_amdgcn_exp2f(S[bk][i] - mnew); S[bk][i] = pe; ps += pe; }
                l[bq] = l[bq] * alpha + ps;
#pragma unroll
                for (int bd = 0; bd < 2; ++bd)
#pragma unroll
                    for (int i = 0; i < 16; ++i) O[bd][bq][i] *= alpha;
                bf16x8 pf[4];
#pragma unroll
                for (int bk = 0; bk < 2; ++bk)
#pragma unroll
                    for (int s2 = 0; s2 < 2; ++s2) { v4u w; w.x = pkbf(S[bk][8 * s2 + 0], S[bk][8 * s2 + 1]); w.y = pkbf(S[bk][8 * s2 + 2], S[bk][8 * s2 + 3]);
                        w.z = pkbf(S[bk][8 * s2 + 4], S[bk][8 * s2 + 5]); w.w = pkbf(S[bk][8 * s2 + 6], S[bk][8 * s2 + 7]); pf[2 * bk + s2] = __builtin_bit_cast(bf16x8, w); }
                if (bq == 0) VM_WAIT(0);
#pragma unroll
                for (int ks = 0; ks < 4; ++ks)
#pragma unroll
                    for (int bd = 0; bd < 2; ++bd) { const int R0 = 16 * ks + 4 * h + q4, c16 = 4 * bd + 2 * blk + (p4 >> 1);
                        const s16x4 lo = trread(Vt + swz(R0, c16) + 8 * (p4 & 1)), hi = trread(Vt + swz(R0 + 8, c16) + 8 * (p4 & 1));
                        const bf16x8 vf = __builtin_shufflevector(lo, hi, 0, 1, 2, 3, 4, 5, 6, 7);
                        O[bd][bq] = MFMA32(vf, pf[ks], O[bd][bq]); }
                __builtin_amdgcn_sched_barrier(0);
            }
            LG_WAIT();
            if (has_next) dma_tile(Vg + (size_t)(u - 8 + jt + 1) * 64 * INW, Vt, vo0, vo1);
        }
        const GAS float* gB = (const GAS float*)gateB; asm volatile("" : "+s"(gB));
        LAS float* sq = ssq + (ucount & 1) * 512;
#pragma unroll
        for (int bq = 0; bq < 2; ++bq) { const float lt = l[bq] + __shfl_xor(l[bq], 32), inv = 1.f / lt; float ss = 0.f;
#pragma unroll
            for (int bd = 0; bd < 2; ++bd)
#pragma unroll
                for (int i = 0; i < 16; ++i) { const float o = O[bd][bq][i] * inv; O[bd][bq][i] = o; ss += o * o; }
            ss += __shfl_xor(ss, 32);
            if (h == 0) sq[hd * 64 + 32 * bq + r] = ss; }
        __syncthreads();
#pragma unroll
        for (int bq = 0; bq < 2; ++bq) { float tot = 0.f;
#pragma unroll
            for (int hh = 0; hh < 8; ++hh) tot += sq[hh * 64 + 32 * bq + r];
            const float rms = 1.f / sqrtf(tot * (1.f / 512.f) + 1e-6f);
#pragma unroll
            for (int bd = 0; bd < 2; ++bd)
#pragma unroll
                for (int i4 = 0; i4 < 4; ++i4) { const int d = 32 * bd + 8 * i4 + 4 * h; const f32x4 gv = *(const GAS f32x4*)(gB + hd * 64 + d);
                    v2u w; w.x = pkbf(O[bd][bq][4 * i4] * rms * gv[0], O[bd][bq][4 * i4 + 1] * rms * gv[1]); w.y = pkbf(O[bd][bq][4 * i4 + 2] * rms * gv[2], O[bd][bq][4 * i4 + 3] * rms * gv[3]);
                    *(LAS v2u*)(Kt + (32 * bq + r) * 144 + d * 2) = w; } }
        LG_WAIT();
#pragma unroll
        for (int it = 0; it < 8; ++it) { const int row = (lane >> 3) + 8 * it, cp = lane & 7; const v4u v = *(LAS v4u*)(Kt + row * 144 + cp * 16);
            *(v4u*)((char*)(Y + tok0 * D_ + 512 + hd * 64) + (size_t)(it * 8 * D_ * 2) + (unsigned)((lane >> 3) * (D_ * 2) + cp * 16)) = v; }
        LG_WAIT();
    }
}

__device__ __forceinline__ void gmlp_phase(const bf16* Z, const bf16* WSM, const float* lg, const float* lb, const float* bsp, const float* gateA, bf16* Y, LAS unsigned char* lds, int lane, int wave) {
    lane = lane_id_opaque();
    const int r = lane & 31, h = lane >> 5, g = wave, rl = lane >> 3, cp = lane & 7;
    LAS unsigned char* T = lds + wave * 16384;
    LAS float* ssq = (LAS float*)(lds + MX_SSQG);
    const int q4 = (lane & 15) >> 2, p4 = lane & 3, blk = (lane >> 4) & 1;
    float lgv[8], lbv[8];
#pragma unroll
    for (int e = 0; e < 8; ++e) { lgv[e] = lg[g * 64 + cp * 8 + e]; lbv[e] = lb[g * 64 + cp * 8 + e]; }
    int ucount = 0;
    for (int u = blockIdx.x; u < M_ / 128; u += gridDim.x, ++ucount) {
        const size_t tok0 = (size_t)u * 128;
#pragma unroll 4
        for (int it = 0; it < 16; ++it) { const int pos = rl + 8 * it; const v4u w = *(const v4u*)((const char*)(Z + tok0 * INW + 512 + g * 64) + (size_t)(it * 8 * INW * 2) + (unsigned)(rl * (INW * 2) + cp * 16));
            float f[8]; UNPACK8(w, f); float s = 0.f;
#pragma unroll
            for (int e = 0; e < 8; ++e) s += f[e];
            s += __shfl_xor(s, 1); s += __shfl_xor(s, 2); s += __shfl_xor(s, 4);
            const float mean = s * (1.f / 64.f); float s2 = 0.f;
#pragma unroll
            for (int e = 0; e < 8; ++e) { f[e] -= mean; s2 += f[e] * f[e]; }
            s2 += __shfl_xor(s2, 1); s2 += __shfl_xor(s2, 2); s2 += __shfl_xor(s2, 4);
            const float rstd = 1.f / sqrtf(s2 * (1.f / 64.f) + 1e-5f);
#pragma unroll
            for (int e = 0; e < 8; ++e) f[e] = f[e] * rstd * lgv[e] + lbv[e];
            v4u o; o.x = pkbf(f[0], f[1]); o.y = pkbf(f[2], f[3]); o.z = pkbf(f[4], f[5]); o.w = pkbf(f[6], f[7]);
            *(LAS v4u*)(T + swz(pos, cp)) = o; }
        LG_WAIT();
        LAS float* sq = ssq + (ucount & 1) * 1024;
        const GAS float* gA = (const GAS float*)gateA; asm volatile("" : "+s"(gA)); const GAS float* bsq = (const GAS float*)bsp; asm volatile("" : "+s"(bsq));
        LAS unsigned char* SR = T + 8192;
#pragma unroll
        for (int half = 0; half < 2; ++half) {
            const int bib = half == 0 ? 2 : 0, ns = half == 0 ? 8 : 4;
            f32x16 acc[2][2];
#pragma unroll
            for (int a = 0; a < 2; ++a)
#pragma unroll
                for (int b = 0; b < 2; ++b)
#pragma unroll
                    for (int i = 0; i < 16; ++i) acc[a][b][i] = 0.f;
#pragma unroll
            for (int s = 0; s < ns; ++s) { bf16x8 af[2];
#pragma unroll
                for (int bc = 0; bc < 2; ++bc) { const int R0 = 16 * s + 8 * h + q4, c16 = 4 * bc + 2 * blk + (p4 >> 1);
                    const s16x4 lo = trread(T + swz(R0, c16) + 8 * (p4 & 1)), hi = trread(T + swz(R0 + 4, c16) + 8 * (p4 & 1));
                    af[bc] = __builtin_shufflevector(lo, hi, 0, 1, 2, 3, 4, 5, 6, 7); }
#pragma unroll
                for (int b2 = 0; b2 < 2; ++b2) { const bf16x8 wf = *(const bf16x8*)((const char*)(WSM + ((size_t)g * 128 + 32 * (bib + b2)) * 128 + 16 * s) + (unsigned)(r * 256 + h * 16));
                    acc[0][b2] = MFMA32(af[0], wf, acc[0][b2]); acc[1][b2] = MFMA32(af[1], wf, acc[1][b2]); } }
            LG_WAIT();
#pragma unroll
            for (int b2 = 0; b2 < 2; ++b2) { const int ti = 32 * (bib + b2) + r; const float bsv = bsq[g * 128 + ti]; const char* ub = (const char*)(Z + (tok0 + 32 * (bib + b2)) * INW + g * 64); const unsigned uvo = (unsigned)(r * (INW * 2) + h * 8); float ss = 0.f;
#pragma unroll
                for (int bc = 0; bc < 2; ++bc)
#pragma unroll
                    for (int i4 = 0; i4 < 4; ++i4) { const v2u uw = *(const v2u*)(ub + (size_t)(64 * bc + 16 * i4) + uvo);
                        const float u0 = bflo(uw.x), u1 = bfhi(uw.x), u2 = bflo(uw.y), u3 = bfhi(uw.y);
                        const float y0 = u0 * (acc[bc][b2][4 * i4] + bsv), y1 = u1 * (acc[bc][b2][4 * i4 + 1] + bsv), y2 = u2 * (acc[bc][b2][4 * i4 + 2] + bsv), y3 = u3 * (acc[bc][b2][4 * i4 + 3] + bsv);
                        acc[bc][b2][4 * i4] = y0; acc[bc][b2][4 * i4 + 1] = y1; acc[bc][b2][4 * i4 + 2] = y2; acc[bc][b2][4 * i4 + 3] = y3;
                        ss += (y0 * y0 + y1 * y1) + (y2 * y2 + y3 * y3); }
                ss += __shfl_xor(ss, 32);
                if (h == 0) sq[g * 128 + ti] = ss; }
            __syncthreads();
#pragma unroll
            for (int b2 = 0; b2 < 2; ++b2) { const int ti = 32 * (bib + b2) + r; float tot = 0.f;
#pragma unroll
                for (int gg = 0; gg < 8; ++gg) tot += sq[gg * 128 + ti];
                const float rms = 1.f / sqrtf(tot * (1.f / 512.f) + 1e-6f);
#pragma unroll
                for (int bc = 0; bc < 2; ++bc)
#pragma unroll
                    for (int i4 = 0; i4 < 4; ++i4) { const int cc = 32 * bc + 8 * i4 + 4 * h; const f32x4 gv = *(const GAS f32x4*)(gA + g * 64 + cc);
                        v2u w; w.x = pkbf(acc[bc][b2][4 * i4] * rms * gv[0], acc[bc][b2][4 * i4 + 1] * rms * gv[1]); w.y = pkbf(acc[bc][b2][4 * i4 + 2] * rms * gv[2], acc[bc][b2][4 * i4 + 3] * rms * gv[3]);
                        *(LAS v2u*)(SR + swz(32 * b2 + r, 4 * bc + i4) + 8 * h) = w; } }
            LG_WAIT();
#pragma unroll
            for (int it = 0; it < 8; ++it) { const int row = rl + 8 * it; const v4u v = *(LAS v4u*)(SR + swz(row, cp));
                *(v4u*)((char*)(Y + (tok0 + 32 * bib) * D_ + g * 64) + (size_t)(it * 8 * D_ * 2) + (unsigned)(rl * (D_ * 2) + cp * 16)) = v; }
            LG_WAIT();
        }
    }
}

__global__ void __launch_bounds__(512, 2) fwd_mega(Params p) {
    extern __shared__ __attribute__((aligned(16))) unsigned char lds_raw[];
    cg::grid_group grid = cg::this_grid();
    LAS unsigned char* lds = (LAS unsigned char*)lds_raw;
    const int wave = __builtin_amdgcn_readfirstlane(threadIdx.x >> 6);
    const int G = gridDim.x;
    unsigned char* ws = p.ws;
    bf16* XB = (bf16*)(ws + WS_XB); bf16* Z = (bf16*)(ws + WS_Z); bf16* Y = (bf16*)(ws + WS_Y); bf16* F = (bf16*)(ws + WS_F);
    float* H1 = (float*)(ws + WS_H1); bf16* H1B = (bf16*)(ws + WS_H1B);

    prologue(p, lds, wave);
    grid.sync();
    { pg8::Gemm g{XB, (const bf16*)(ws + WS_WIN), M_, INW, D_}; pg8::StaticOrder S; S.init(M_, INW, G, (int)blockIdx.x);
      pg8::EpiAct<1> E{Z, INW, 4};
      pg8::gemm_phase<pg8::EpiAct<1>, pg8::StaticOrder, true, true>(lds, g, S, E, wave); }
    grid.sync();
#if MIX_NAIVE
    { float* Yt = (float*)(ws + WS_YT); bf16* VN = (bf16*)(ws + WS_VN); const int gtid = blockIdx.x * 512 + wave * 64 + lane_id_opaque(), NT = G * 512;
      naive_vn(Z, p.in[2], p.in[3], VN, gtid, NT);
      grid.sync();
      naive_gmlp(Z, VN, p.in[4], p.in[5], Yt, gtid, NT);
      naive_attn(Z, p.in[6], Yt, gtid, NT);
      grid.sync();
      rms_rows(Yt, p.in[7], p.in[8], Y, wave); }
#else
    gmlp_phase(Z, (const bf16*)(ws + WS_WSM), p.in[2], p.in[3], p.in[5], p.in[7], Y, lds, 0, wave);
    attn_phase(Z, p.in[6], p.in[8], Y, lds, 0, wave);
#endif
    grid.sync();
    { pg8::Gemm g{Y, (const bf16*)(ws + WS_WOUT), M_, D_, D_}; pg8::StaticOrder S; S.init(M_, D_, G, (int)blockIdx.x);
      pg8::EpiRes E{p.in[0], H1, D_, ALPHA};
      pg8::gemm_phase<pg8::EpiRes, pg8::StaticOrder, true, true>(lds, g, S, E, wave); }
    grid.sync();
    ln_rows(H1, p.in[10], p.in[11], H1, H1B, wave);
    grid.sync();
    { pg8::Gemm g{H1B, (const bf16*)(ws + WS_W1), M_, FF_, D_}; pg8::StaticOrder S; S.init(M_, FF_, G, (int)blockIdx.x);
      pg8::EpiAct<2> E{F, FF_, 0};
      pg8::gemm_phase<pg8::EpiAct<2>, pg8::StaticOrder, true, true>(lds, g, S, E, wave); }
    grid.sync();
    { pg8::Gemm g{F, (const bf16*)(ws + WS_W2), M_, D_, FF_}; pg8::StaticOrder S; S.init(M_, D_, G, (int)blockIdx.x);
      pg8::EpiRes E{H1, p.out, D_, ALPHA};
      pg8::gemm_phase<pg8::EpiRes, pg8::StaticOrder, true, true>(lds, g, S, E, wave); }
    grid.sync();
    ln_rows(p.out, p.in[14], p.in[15], p.out, nullptr, wave);
}

extern "C" void kernel_launch(void* const* d_in, const int* in_sizes, int n_in, void* d_out, int out_size, void* d_ws, size_t ws_size, hipStream_t stream) {
    static int grid = 0;
    if (grid == 0) {
        if (n_in != 16 || in_sizes[0] != M_ * D_ || out_size != M_ * D_ || ws_size < WS_END) { fprintf(stderr, "kernel_launch: unexpected shapes (n_in %d, in0 %d, out %d, ws %zu)\n", n_in, n_in > 0 ? in_sizes[0] : -1, out_size, ws_size); grid = -1; return; }
        int dev = 0, cus = 0, per_cu = 0;
        (void)hipGetDevice(&dev); (void)hipDeviceGetAttribute(&cus, hipDeviceAttributeMultiprocessorCount, dev);
        if (hipFuncSetAttribute((const void*)fwd_mega, hipFuncAttributeMaxDynamicSharedMemorySize, LDS_BYTES) != hipSuccess) { fprintf(stderr, "kernel_launch: hipFuncSetAttribute failed\n"); grid = -1; return; }
        if (hipOccupancyMaxActiveBlocksPerMultiprocessor(&per_cu, (const void*)fwd_mega, 512, LDS_BYTES) != hipSuccess || per_cu < 1) { fprintf(stderr, "kernel_launch: occupancy query says %d blocks per CU\n", per_cu); (void)hipGetLastError(); per_cu = 1; }
        grid = cus * (per_cu > 1 ? 1 : per_cu);
    }
    if (grid < 0) return;
    Params p{};
    for (int i = 0; i < 16; ++i) p.in[i] = (const float*)d_in[i];
    p.out = (float*)d_out; p.ws = (unsigned char*)d_ws;
    void* args[] = {&p};
    hipError_t e = hipLaunchCooperativeKernel((const void*)fwd_mega, dim3(grid), dim3(512), args, LDS_BYTES, stream);
    if (e != hipSuccess) fprintf(stderr, "kernel_launch: cooperative launch failed: %s (grid %d)\n", hipGetErrorString(e), grid);
}
```
